# Optimizing an MI355X kernel written in HIP

```python
import jax, jax.numpy as jnp
from jax import lax
import numpy as np

D_MODEL = 1024
BATCH = 8
SEQ = 4096
DEPTH = 4

ATT_HEADS = 8
ATT_HEAD_DIM = 64
ATT_ROPE_DIM = ATT_HEAD_DIM // 4
ATT_ROPE_THETA = 500000.0
DILATED_GROUPS = ((128, 1), (512, 4), (2048, 16))
RET_HEADS = 8
RET_QK_DIM = 64
RET_V_DIM = 2 * RET_QK_DIM
RET_THETA = 10000.0
RET_CHUNK = 128
D_FF = 4 * D_MODEL
PLE_DIM = 256
NORM_EPS = 1e-6
GN_EPS = 1e-5
MASK_VALUE = -1e30

ATT_W = ATT_HEADS * ATT_HEAD_DIM
RET_QK_W = RET_HEADS * RET_QK_DIM
RET_V_W = RET_HEADS * RET_V_DIM
IN_SPLITS = (ATT_W, ATT_W, ATT_W, RET_QK_W, RET_QK_W, RET_V_W, RET_V_W, D_MODEL, D_MODEL)
IN_WIDTH = sum(IN_SPLITS)

kernel_name = "hybrid_dilated_attn_retention_block"


def rms_norm(x, gain=None):
    xf = x.astype(jnp.float32)
    y = xf * lax.rsqrt(jnp.mean(xf * xf, axis=-1, keepdims=True) + NORM_EPS)
    if gain is not None:
        y = y * gain.astype(jnp.float32)
    return y.astype(x.dtype)


def rotate(x, pos, rot_dim, theta):
    half = rot_dim // 2
    inv = theta ** (-jnp.arange(half, dtype=jnp.float32) * 2.0 / rot_dim)
    ang = pos.astype(jnp.float32)[:, None] * inv[None, :]
    cos = jnp.cos(ang)[:, None, :]
    sin = jnp.sin(ang)[:, None, :]
    xr = x[..., :rot_dim].astype(jnp.float32)
    x1, x2 = xr[..., :half], xr[..., half:]
    rot = jnp.concatenate([x1 * cos - x2 * sin, x2 * cos + x1 * sin], axis=-1).astype(x.dtype)
    return jnp.concatenate([rot, x[..., rot_dim:]], axis=-1)


def dilated_band_attention(q, k, v, dilation, half_width):
    b, s, h, dh = q.shape
    r = dilation
    L = s // r
    blk = half_width
    nb = -(-L // blk)
    Lp = nb * blk

    def to_sub(t):
        return t.reshape(b, L, r, h, dh).transpose(0, 2, 3, 1, 4)

    qs = jnp.pad(to_sub(q), ((0, 0), (0, 0), (0, 0), (0, Lp - L), (0, 0))).reshape(b, r, h, nb, blk, dh)

    def windows(t):
        t = jnp.pad(to_sub(t), ((0, 0), (0, 0), (0, 0), (blk, Lp - L + blk), (0, 0))).reshape(b, r, h, nb + 2, blk, dh)
        return jnp.concatenate([t[:, :, :, :-2], t[:, :, :, 1:-1], t[:, :, :, 2:]], axis=4)

    kw, vw = windows(k), windows(v)
    scores = jnp.einsum('brhnqd,brhnkd->brhnqk', qs.astype(jnp.float32), kw.astype(jnp.float32)) * (dh ** -0.5)
    qi = jnp.arange(blk)
    kj = jnp.arange(3 * blk)
    rel = qi[:, None] - kj[None, :] + blk
    key_idx = jnp.arange(nb)[:, None] * blk + kj[None, :] - blk
    valid = ((jnp.abs(rel) <= half_width)[None]
             & ((key_idx >= 0) & (key_idx < L))[:, None, :])
    scores = jnp.where(valid, scores, MASK_VALUE)
    lse = jax.nn.logsumexp(scores, axis=-1)
    probs = jnp.exp(scores - lse[..., None])
    out = jnp.einsum('brhnqk,brhnkd->brhnqd', probs, vw.astype(jnp.float32))
    out = out.reshape(b, r, h, Lp, dh)[:, :, :, :L].transpose(0, 3, 1, 2, 4).reshape(b, s, h, dh)
    lse = lse.reshape(b, r, h, Lp)[..., :L].transpose(0, 3, 1, 2).reshape(b, s, h)
    return out, lse


def dilated_attention_mixer(q, k, v):
    b, s, _ = q.shape
    pos = jnp.arange(s)
    q = rotate(q.reshape(b, s, ATT_HEADS, ATT_HEAD_DIM), pos, ATT_ROPE_DIM, ATT_ROPE_THETA)
    k = rotate(k.reshape(b, s, ATT_HEADS, ATT_HEAD_DIM), pos, ATT_ROPE_DIM, ATT_ROPE_THETA)
    v = v.reshape(b, s, ATT_HEADS, ATT_HEAD_DIM)
    outs, lses = [], []
    for window, dil in DILATED_GROUPS:
        o, l = dilated_band_attention(q, k, v, dil, window // (2 * dil))
        outs.append(o)
        lses.append(l)
    weights = jax.nn.softmax(jnp.stack(lses, axis=0), axis=0)
    out = jnp.sum(weights[..., None] * jnp.stack(outs, axis=0), axis=0)
    return out.reshape(b, s, ATT_W).astype(v.dtype)


def retention_direction(q, k, v, log_gamma, include_diag):
    b, h, s, dk = q.shape
    dv = v.shape[-1]
    c = RET_CHUNK
    n = s // c
    qc = q.reshape(b, h, n, c, dk)
    kc = k.reshape(b, h, n, c, dk)
    vc = v.reshape(b, h, n, c, dv)
    idx = jnp.arange(c, dtype=jnp.float32)
    diff = idx[:, None] - idx[None, :]
    inside = (diff >= 0) if include_diag else (diff > 0)
    lg = log_gamma[:, None, None]
    decay = jnp.where(inside[None], jnp.exp(jnp.maximum(diff, 0.0)[None] * lg), 0.0)
    intra = jnp.einsum('bhnid,bhnjd->bhnij', qc, kc) * decay[None, :, None]
    intra = jnp.einsum('bhnij,bhnje->bhnie', intra, vc)
    zeta = jnp.exp((c - 1 - idx)[None, :] * log_gamma[:, None])
    xi = jnp.exp((idx + 1)[None, :] * log_gamma[:, None])
    kv = jnp.einsum('bhnjd,bhnje->nbhde', kc * zeta[None, :, None, :, None], vc)
    chunk_decay = jnp.exp(c * log_gamma)[None, :, None, None]

    def step(state, kv_n):
        return chunk_decay * state + kv_n, state

    _, prev = lax.scan(step, jnp.zeros((b, h, dk, dv), jnp.float32), kv)
    cross = jnp.einsum('bhnid,nbhde->bhnie', qc * xi[None, :, None, :, None], prev)
    return (intra + cross).reshape(b, h, s, dv)


def retention_mixer(q, k, v, g, decay_logit):
    b, s, _ = q.shape
    pos = jnp.arange(s)
    q = rotate(q.reshape(b, s, RET_HEADS, RET_QK_DIM), pos, RET_QK_DIM, RET_THETA)
    k = rotate(k.reshape(b, s, RET_HEADS, RET_QK_DIM), pos, RET_QK_DIM, RET_THETA)
    q = q.astype(jnp.float32).transpose(0, 2, 1, 3)
    k = k.astype(jnp.float32).transpose(0, 2, 1, 3) * (RET_QK_DIM ** -0.5)
    v = v.reshape(b, s, RET_HEADS, RET_V_DIM).astype(jnp.float32).transpose(0, 2, 1, 3)
    log_gamma = jax.nn.log_sigmoid(decay_logit.astype(jnp.float32))
    fwd = retention_direction(q, k, v, log_gamma[0], True)
    bwd = retention_direction(jnp.flip(q, 2), jnp.flip(k, 2), jnp.flip(v, 2), log_gamma[1], False)
    y = fwd + jnp.flip(bwd, 2)
    mu = jnp.mean(y, axis=-1, keepdims=True)
    var = jnp.mean(jnp.square(y - mu), axis=-1, keepdims=True)
    y = (y - mu) * lax.rsqrt(var + GN_EPS)
    y = y.transpose(0, 2, 1, 3).reshape(b, s, RET_V_W)
    return (jax.nn.silu(g.astype(jnp.float32)) * y).astype(g.dtype)


def setup_inputs(seed: int = 0) -> dict:
    key = jax.random.key(seed)
    ks = jax.random.split(key, 16)

    def dense(k, shape, fan_in):
        return jax.random.normal(k, shape, jnp.float32) * (fan_in ** -0.5)

    def gain(k):
        return 1.0 + 0.05 * jax.random.normal(k, (DEPTH, D_MODEL), jnp.float32)

    expo = 5.0 + jnp.arange(RET_HEADS, dtype=jnp.float32)
    base_logit = jnp.log(jnp.exp2(expo) - 1.0)
    ret_decay_logit = base_logit[None, None, :] + 0.1 * jax.random.normal(ks[10], (DEPTH, 2, RET_HEADS), jnp.float32)
    return {
        "x": jax.random.normal(ks[0], (BATCH, SEQ, D_MODEL), jnp.float32),
        "p": jax.random.normal(ks[1], (DEPTH, BATCH, SEQ, PLE_DIM), jnp.float32),
        "w_in": dense(ks[2], (DEPTH, D_MODEL, IN_WIDTH), D_MODEL),
        "w_att_out": dense(ks[3], (DEPTH, ATT_W, D_MODEL), ATT_W),
        "w_ret_out": dense(ks[4], (DEPTH, RET_V_W, D_MODEL), RET_V_W),
        "w_out": dense(ks[5], (DEPTH, D_MODEL, D_MODEL), D_MODEL),
        "w_mlp_up": dense(ks[6], (DEPTH, D_MODEL, D_FF), D_MODEL),
        "w_mlp_down": dense(ks[7], (DEPTH, D_FF, D_MODEL), D_FF),
        "w_ple_gate": dense(ks[8], (DEPTH, D_MODEL, D_MODEL), D_MODEL),
        "w_ple_proj": dense(ks[9], (DEPTH, PLE_DIM, D_MODEL), PLE_DIM),
        "ret_decay_logit": ret_decay_logit,
        "norm_mix_pre": gain(ks[11]),
        "norm_mix_post": gain(ks[12]),
        "norm_mlp_pre": gain(ks[13]),
        "norm_mlp_post": gain(ks[14]),
        "norm_ple": gain(ks[15]),
    }


def reference(x, p, w_in, w_att_out, w_ret_out, w_out, w_mlp_up, w_mlp_down, w_ple_gate, w_ple_proj,
              ret_decay_logit, norm_mix_pre, norm_mix_post, norm_mlp_pre, norm_mlp_post, norm_ple):
    splits = np.cumsum(IN_SPLITS)[:-1].tolist()
    h = x
    for i in range(DEPTH):
        u = rms_norm(h, norm_mix_pre[i])
        proj = u @ w_in[i]
        qa, ka, va, qr, kr, vr, gr, gate_a, gate_b = jnp.split(proj, splits, axis=-1)
        att = dilated_attention_mixer(qa, ka, va)
        ret = retention_mixer(qr, kr, vr, gr, ret_decay_logit[i])
        merged = (jax.nn.sigmoid(gate_a) * (att @ w_att_out[i])
                  + jax.nn.sigmoid(gate_b) * (ret @ w_ret_out[i]))
        h = h + rms_norm(merged @ w_out[i], norm_mix_post[i])
        u = rms_norm(h, norm_mlp_pre[i])
        ff = jnp.square(jax.nn.relu(u @ w_mlp_up[i])) @ w_mlp_down[i]
        h = h + rms_norm(ff, norm_mlp_post[i])
        gate = jax.nn.sigmoid(rms_norm(h) @ w_ple_gate[i])
        h = h + gate * rms_norm(p[i] @ w_ple_proj[i], norm_ple[i])
    return h
```

```cpp
#include <hip/hip_runtime.h>
#include <hip/hip_cooperative_groups.h>
#include <cstdio>
#include <cstdint>
namespace cg = cooperative_groups;

#define LAS __attribute__((address_space(3)))
typedef unsigned short bf16_t;
typedef short bf16x8 __attribute__((ext_vector_type(8)));
typedef short s16x4 __attribute__((ext_vector_type(4)));
typedef short v4i16_t __attribute__((ext_vector_type(4)));
typedef float f32x4 __attribute__((ext_vector_type(4)));
typedef float f32x2 __attribute__((ext_vector_type(2)));
typedef unsigned u32x4 __attribute__((ext_vector_type(4)));
typedef unsigned u32x2 __attribute__((ext_vector_type(2)));

constexpr int M = 32768, D = 1024, SEQ = 4096, DEPTH = 4, FF = 4096, PLE = 256;
constexpr int LDP = 4608;
constexpr int C_QA = 0, C_KA = 512, C_VA = 1024, C_QR = 1536, C_KR = 2048, C_VR = 2560, C_GR = 3584;
constexpr int C_S1 = 512, C_S2 = 1536, C_Y = 3584;
constexpr float NORM_EPS = 1e-6f, GN_EPS = 1e-5f;
constexpr size_t MiB = 1u << 20;
constexpr size_t WS_WB = 0;
constexpr size_t WB_IN = 0, WB_GA = (size_t)4608 * 1024, WB_GB = (size_t)5632 * 1024, WB_AO = (size_t)6656 * 1024, WB_RO = WB_AO + 1024 * 512,
                 WB_WO = WB_RO + 1024 * 1024, WB_UP = WB_WO + 1024 * 1024, WB_DN = WB_UP + 4096 * 1024, WB_PG = WB_DN + 4096 * 1024, WB_PP = WB_PG + 1024 * 1024;
constexpr size_t WS_TABA = 37 * MiB, WS_TABR = WS_TABA + 4096 * 8 * 8;
constexpr size_t WS_CTL = 38 * MiB + 512 * 1024;
constexpr size_t WS_RS = 39 * MiB, WS_PART = 40 * MiB;
constexpr size_t WS_HB = 42 * MiB, WS_PB = 106 * MiB, WS_KV = 122 * MiB, WS_PROJ = 186 * MiB, WS_END = 474 * MiB;
constexpr int LDS_BYTES = 147456;

typedef __bf16 bf16x2_t __attribute__((ext_vector_type(2)));
__device__ __forceinline__ unsigned cvt_pk_bf16(float lo, float hi) { const f32x2 v = {lo, hi}; const bf16x2_t b = __builtin_convertvector(v, bf16x2_t); return __builtin_bit_cast(unsigned, b); }
__device__ __forceinline__ float bflo(unsigned w) { return __uint_as_float(w << 16); }
__device__ __forceinline__ float bfhi(unsigned w) { return __uint_as_float(w & 0xffff0000u); }
__device__ __forceinline__ float sigmoidf_(float x) { return __builtin_amdgcn_rcpf(1.0f + __expf(-x)); }
__device__ __forceinline__ float wave_sum(float v) {
#pragma unroll
    for (int o = 1; o < 64; o <<= 1) v += __shfl_xor(v, o);
    return v;
}
__device__ __forceinline__ float logsig(float x) { return -log1pf(expf(-x)); }
__device__ __forceinline__ s16x4 tr_read(LAS unsigned char* p) { return __builtin_bit_cast(s16x4, __builtin_amdgcn_ds_read_tr16_b64_v4i16((LAS v4i16_t*)p)); }
__device__ __forceinline__ bf16x8 cat8(s16x4 lo, s16x4 hi) { return (bf16x8){lo[0], lo[1], lo[2], lo[3], hi[0], hi[1], hi[2], hi[3]}; }
__device__ __forceinline__ bf16x8 pack8(f32x4 a, f32x4 b) { u32x4 w; w.x = cvt_pk_bf16(a[0], a[1]); w.y = cvt_pk_bf16(a[2], a[3]); w.z = cvt_pk_bf16(b[0], b[1]); w.w = cvt_pk_bf16(b[2], b[3]); return __builtin_bit_cast(bf16x8, w); }
__device__ __forceinline__ u32x4 scale8(u32x4 w, float s) {
    u32x4 o; o.x = cvt_pk_bf16(bflo(w.x) * s, bfhi(w.x) * s); o.y = cvt_pk_bf16(bflo(w.y) * s, bfhi(w.y) * s);
    o.z = cvt_pk_bf16(bflo(w.z) * s, bfhi(w.z) * s); o.w = cvt_pk_bf16(bflo(w.w) * s, bfhi(w.w) * s); return o;
}

namespace pg8 {
constexpr int BM = 256, BK = 64, HALF = 128, HTB = HALF * BK * 2, STAGE_BYTES = 8 * HTB, NXCD = 8, WGM = 8;
__host__ __device__ __forceinline__ int lds_byte(int r, int c) { const int st = (r >> 4) * 2 + (c >> 5), rr = r & 15, cc = c & 31, ob = rr * 64 + cc * 2; return st * 1024 + (ob ^ (((ob >> 9) & 1) << 5)); }
__host__ __device__ __forceinline__ void stage_rc(int b, int& R, int& C) { const int st = b / 1024, sb = b % 1024, swz = sb ^ (((sb >> 9) & 1) << 5); R = (st >> 1) * 16 + swz / 64; C = (st & 1) * 32 + (swz % 64) / 2; }
__host__ __device__ __forceinline__ int perm32(int rho) { const int n = rho >> 4, i = rho & 15; return 8 * (i >> 2) + 4 * n + (i & 3); }
struct Unit { int pm, pn; };
struct Gemm { const bf16_t* A; const bf16_t* Bt; int M, N, K, lda, ldb; };
struct StaticOrder {
    int nM, nN, nwg, G, c;
    __device__ void init(int M_, int N_, int G_, int c_) { nM = M_ / BM; nN = N_ / BM; nwg = nM * nN; G = G_; c = c_; }
    __device__ bool next(int i, Unit& u) const {
        const long L = (long)i * G + c; if (L >= nwg) return false;
        int wgid = (int)L; { const int q = nwg / NXCD, r = nwg % NXCD, xcd = wgid % NXCD, off = wgid / NXCD; wgid = (xcd < r ? xcd * (q + 1) : r * (q + 1) + (xcd - r) * q) + off; }
        const int nig = WGM * nN, gid = wgid / nig, fm = gid * WGM, gsz = (nM - fm) < WGM ? (nM - fm) : WGM;
        u.pm = fm + ((wgid % nig) % gsz); u.pn = (wgid % nig) / gsz; return true;
    }
};
#define EPI_ARGS const f32x4 (&acc)[2][2][4][2], const Unit& u, int wr, int wc, int fr, int fq

struct EpiProj {
    static constexpr bool PERM = true;
    bf16_t* O; const float* rs; const f32x2* tabA; const f32x2* tabR;
    __device__ __forceinline__ void operator()(EPI_ARGS) const {
        const int pn = u.pn; int kind = 0; float sc = 1.f;
        if (pn < 2) { kind = 1; sc = 0.125f; } else if (pn < 4) kind = 1; else if (pn < 6) kind = 0; else if (pn < 8) kind = 2; else if (pn < 10) { kind = 2; sc = 0.125f; } else if (pn < 14) kind = 0; else kind = 3;
        const int row0 = u.pm * BM + wr * 64 + fr, colb = pn * BM + wc * 32 + 8 * fq;
#pragma unroll
        for (int ai = 0; ai < 2; ++ai)
#pragma unroll
            for (int m = 0; m < 4; ++m) {
                const int row = row0 + ai * HALF + m * 16; const float r = rs[row] * sc; const int pos = row & (SEQ - 1);
#pragma unroll
                for (int bj = 0; bj < 2; ++bj) {
                    const int c0 = colb + bj * HALF; f32x4 v0 = acc[ai][bj][m][0] * r, v1 = acc[ai][bj][m][1] * r;
                    if (kind == 1 || kind == 2) {
                        const int cm = c0 & 63;
                        if (kind == 2 || cm < 16) {
                            const f32x4* t = (kind == 1) ? (const f32x4*)(tabA + pos * 8 + (cm >> 1)) : (const f32x4*)(tabR + pos * 32 + (cm >> 1));
                            const f32x4 t0 = t[0], t1 = t[1];
                            f32x4 w0, w1;
                            w0[0] = v0[0] * t0[0] - v0[1] * t0[1]; w0[1] = v0[1] * t0[0] + v0[0] * t0[1]; w0[2] = v0[2] * t0[2] - v0[3] * t0[3]; w0[3] = v0[3] * t0[2] + v0[2] * t0[3];
                            w1[0] = v1[0] * t1[0] - v1[1] * t1[1]; w1[1] = v1[1] * t1[0] + v1[0] * t1[1]; w1[2] = v1[2] * t1[2] - v1[3] * t1[3]; w1[3] = v1[3] * t1[2] + v1[2] * t1[3];
                            v0 = w0; v1 = w1;
                        }
                    } else if (kind == 3) {
#pragma unroll
                        for (int j = 0; j < 4; ++j) { v0[j] = v0[j] * sigmoidf_(v0[j]); v1[j] = v1[j] * sigmoidf_(v1[j]); }
                    }
                    u32x4 w; w.x = cvt_pk_bf16(v0[0], v0[1]); w.y = cvt_pk_bf16(v0[2], v0[3]); w.z = cvt_pk_bf16(v1[0], v1[1]); w.w = cvt_pk_bf16(v1[2], v1[3]);
                    *(u32x4*)(O + (size_t)row * LDP + c0) = w;
                }
            }
    }
};
template <int ACT> struct EpiAct {
    static constexpr bool PERM = true;
    bf16_t* O; int ldc; const float* rs;
    __device__ __forceinline__ void operator()(EPI_ARGS) const {
        const int row0 = u.pm * BM + wr * 64 + fr, colb = u.pn * BM + wc * 32 + 8 * fq;
#pragma unroll
        for (int ai = 0; ai < 2; ++ai)
#pragma unroll
            for (int m = 0; m < 4; ++m) {
                const int row = row0 + ai * HALF + m * 16; const float r = rs[row];
#pragma unroll
                for (int bj = 0; bj < 2; ++bj) {
                    f32x4 v0 = acc[ai][bj][m][0] * r, v1 = acc[ai][bj][m][1] * r;
#pragma unroll
                    for (int j = 0; j < 4; ++j) {
                        if (ACT == 0) { v0[j] = sigmoidf_(v0[j]); v1[j] = sigmoidf_(v1[j]); }
                        else { const float a0 = fmaxf(v0[j], 0.f), a1 = fmaxf(v1[j], 0.f); v0[j] = a0 * a0; v1[j] = a1 * a1; }
                    }
                    u32x4 w; w.x = cvt_pk_bf16(v0[0], v0[1]); w.y = cvt_pk_bf16(v0[2], v0[3]); w.z = cvt_pk_bf16(v1[0], v1[1]); w.w = cvt_pk_bf16(v1[2], v1[3]);
                    *(u32x4*)(O + (size_t)row * ldc + colb + bj * HALF) = w;
                }
            }
    }
};
struct EpiMulAdd {
    static constexpr bool PERM = true;
    bf16_t* S; const bf16_t* T; int ld;
    __device__ __forceinline__ void operator()(EPI_ARGS) const {
        const int row0 = u.pm * BM + wr * 64 + fr, colb = u.pn * BM + wc * 32 + 8 * fq;
#pragma unroll
        for (int ai = 0; ai < 2; ++ai)
#pragma unroll
            for (int m = 0; m < 4; ++m) {
                const int row = row0 + ai * HALF + m * 16;
#pragma unroll
                for (int bj = 0; bj < 2; ++bj) {
                    const size_t off = (size_t)row * ld + colb + bj * HALF;
                    const u32x4 s = *(const u32x4*)(S + off); u32x4 t = (u32x4){0u, 0u, 0u, 0u}; if (T) t = *(const u32x4*)(T + off);
                    const f32x4 a0 = acc[ai][bj][m][0], a1 = acc[ai][bj][m][1];
                    u32x4 w;
                    w.x = cvt_pk_bf16(bflo(t.x) + bflo(s.x) * a0[0], bfhi(t.x) + bfhi(s.x) * a0[1]); w.y = cvt_pk_bf16(bflo(t.y) + bflo(s.y) * a0[2], bfhi(t.y) + bfhi(s.y) * a0[3]);
                    w.z = cvt_pk_bf16(bflo(t.z) + bflo(s.z) * a1[0], bfhi(t.z) + bfhi(s.z) * a1[1]); w.w = cvt_pk_bf16(bflo(t.w) + bflo(s.w) * a1[2], bfhi(t.w) + bfhi(s.w) * a1[3]);
                    *(u32x4*)(S + off) = w;
                }
            }
    }
};
struct EpiY {
    static constexpr bool PERM = true;
    bf16_t* Y; int ldc; float* part;
    __device__ __forceinline__ void operator()(EPI_ARGS) const {
        const int row0 = u.pm * BM + wr * 64 + fr, colb = u.pn * BM + wc * 32 + 8 * fq;
#pragma unroll
        for (int ai = 0; ai < 2; ++ai)
#pragma unroll
            for (int m = 0; m < 4; ++m) {
                const int row = row0 + ai * HALF + m * 16; float s = 0.f;
#pragma unroll
                for (int bj = 0; bj < 2; ++bj) {
                    const f32x4 v0 = acc[ai][bj][m][0], v1 = acc[ai][bj][m][1];
                    s += (v0[0] * v0[0] + v0[1] * v0[1]) + (v0[2] * v0[2] + v0[3] * v0[3]) + (v1[0] * v1[0] + v1[1] * v1[1]) + (v1[2] * v1[2] + v1[3] * v1[3]);
                    u32x4 w; w.x = cvt_pk_bf16(v0[0], v0[1]); w.y = cvt_pk_bf16(v0[2], v0[3]); w.z = cvt_pk_bf16(v1[0], v1[1]); w.w = cvt_pk_bf16(v1[2], v1[3]);
                    *(u32x4*)(Y + (size_t)row * ldc + colb + bj * HALF) = w;
                }
                s += __shfl_xor(s, 16); s += __shfl_xor(s, 32);
                if (fq == 0) part[(size_t)row * 16 + u.pn * 4 + wc] = s;
            }
    }
};

template <class Epi, bool ALIGN_EPI = true>
__device__ __forceinline__ void gemm_phase(LAS unsigned char* lds, const Gemm g, const StaticOrder& S, const Epi& E) {
    int tid_ = threadIdx.x; asm volatile("" : "+v"(tid_));
    const int tid = tid_, wid = __builtin_amdgcn_readfirstlane(tid >> 6), lane = tid & 63, wr = wid >> 2, wc = wid & 3, fr = lane & 15, fq = lane >> 4;
    const int K = g.K, nt = K / BK;
    unsigned voffA[2], voffB[2];
#pragma unroll
    for (int i = 0; i < 2; ++i) { int R, C; stage_rc(tid * 16 + i * 8192, R, C); const int Rb = Epi::PERM ? ((R & ~31) + perm32(R & 31)) : R;
        voffA[i] = (unsigned)(R * g.lda + C) * 2u; voffB[i] = (unsigned)(Rb * g.ldb + C) * 2u; }
    const size_t kstep = (size_t)(BK * 2);
    const size_t hstepA = (size_t)HALF * g.lda * 2, hstepB = (size_t)HALF * g.ldb * 2;
    const size_t tstepA = 2 * hstepA, tstepB = 2 * hstepB;
    const unsigned ldsw = (unsigned)wid * 1024u;
    const int aoff = lds_byte(wr * 64 + fr, fq * 8), boff = lds_byte(wc * 32 + fr, fq * 8);
#define PG8_SA(b, h) (((b) * 2 + (h)) * HTB)
#define PG8_SB(b, h) ((4 + (b) * 2 + (h)) * HTB)
#define PG8_STAGE(bufoff, gbase, voff) do { _Pragma("unroll") for (int _i = 0; _i < 2; ++_i) \
        __builtin_amdgcn_global_load_lds((const unsigned*)((const char*)(gbase) + (voff)[_i]), (LAS unsigned*)(lds + (bufoff) + ldsw + _i * 8192), 16, 0, 0); } while (0)
#define PG8_LDA(dst, b, h) do { _Pragma("unroll") for (int m = 0; m < 4; ++m) _Pragma("unroll") for (int k = 0; k < 2; ++k) dst[m][k] = *(const LAS bf16x8*)(lds + PG8_SA(b, h) + aoff + m * 2048 + k * 1024); } while (0)
#define PG8_LDB(dst, b, h) do { _Pragma("unroll") for (int n = 0; n < 2; ++n) _Pragma("unroll") for (int k = 0; k < 2; ++k) dst[n][k] = *(const LAS bf16x8*)(lds + PG8_SB(b, h) + boff + n * 2048 + k * 1024); } while (0)
#define PG8_MMA(ai, bj, At, Bt) do { __builtin_amdgcn_s_setprio(1); _Pragma("unroll") for (int m = 0; m < 4; ++m) _Pragma("unroll") for (int n = 0; n < 2; ++n) _Pragma("unroll") for (int k = 0; k < 2; ++k) \
        acc[ai][bj][m][n] = __builtin_amdgcn_mfma_f32_16x16x32_bf16(Bt[n][k], At[m][k], acc[ai][bj][m][n], 0, 0, 0); __builtin_amdgcn_s_setprio(0); } while (0)
#define PG8_WAIT_V(n) asm volatile("s_waitcnt vmcnt(" #n ")" ::: "memory")
#define PG8_WAIT_L(n) asm volatile("s_waitcnt lgkmcnt(" #n ")" ::: "memory")
#define PG8_BAR __builtin_amdgcn_s_barrier()
#define PG8_SCHED __builtin_amdgcn_sched_barrier(0)
    Unit cur, nxt; int ui = 0;
    if (!S.next(0, cur)) return;
    f32x4 acc[2][2][4][2];
#pragma unroll
    for (int a = 0; a < 2; ++a)
#pragma unroll
        for (int b = 0; b < 2; ++b)
#pragma unroll
            for (int m = 0; m < 4; ++m)
#pragma unroll
                for (int n = 0; n < 2; ++n) acc[a][b][m][n] = (f32x4){0.f, 0.f, 0.f, 0.f};
    bf16x8 At[4][2], B0[2][2], B1[2][2];
    const char* cA = (const char*)g.A + (size_t)cur.pm * tstepA; const char* cB = (const char*)g.Bt + (size_t)cur.pn * tstepB;
    PG8_STAGE(PG8_SB(0, 0), cB, voffB); PG8_STAGE(PG8_SB(0, 1), cB + hstepB, voffB); PG8_STAGE(PG8_SA(0, 0), cA, voffA); PG8_STAGE(PG8_SA(0, 1), cA + hstepA, voffA);
    if (wr == 1) PG8_BAR;
    PG8_WAIT_V(2); PG8_BAR;
    PG8_STAGE(PG8_SB(1, 0), cB + kstep, voffB); PG8_STAGE(PG8_SA(1, 0), cA + kstep, voffA); PG8_STAGE(PG8_SB(1, 1), cB + hstepB + kstep, voffB);
    PG8_WAIT_V(6); PG8_BAR;
    for (;;) {
        const bool has_next = S.next(ui + 1, nxt);
        const char* nA = has_next ? (const char*)g.A + (size_t)nxt.pm * tstepA : cA; const char* nB = has_next ? (const char*)g.Bt + (size_t)nxt.pn * tstepB : cB;
#pragma unroll 1
        for (int t = 0; t < nt; t += 2) {
            const bool last = (t == nt - 2);
            const char* a1 = cA + (size_t)(t + 1) * kstep;
            const char* a2 = last ? nA : cA + (size_t)(t + 2) * kstep; const char* b2 = last ? nB : cB + (size_t)(t + 2) * kstep;
            const char* a3 = a2 + kstep; const char* b3 = b2 + kstep;
            PG8_LDB(B0, 0, 0); PG8_LDB(B1, 0, 1); PG8_SCHED; PG8_LDA(At, 0, 0); PG8_STAGE(PG8_SA(1, 1), a1 + hstepA, voffA);
            PG8_WAIT_V(8); PG8_WAIT_L(0); PG8_BAR; PG8_MMA(0, 0, At, B0); PG8_MMA(0, 1, At, B1); PG8_BAR; PG8_SCHED;
            PG8_LDA(At, 0, 1); PG8_STAGE(PG8_SB(0, 0), b2, voffB); PG8_STAGE(PG8_SB(0, 1), b2 + hstepB, voffB); PG8_STAGE(PG8_SA(0, 0), a2, voffA);
            PG8_WAIT_V(8); PG8_WAIT_L(0); PG8_BAR; PG8_MMA(1, 0, At, B0); PG8_MMA(1, 1, At, B1); PG8_BAR; PG8_SCHED;
            PG8_LDB(B0, 1, 0); PG8_LDB(B1, 1, 1); PG8_SCHED; PG8_LDA(At, 1, 0); PG8_STAGE(PG8_SA(0, 1), a2 + hstepA, voffA);
            PG8_WAIT_V(8); PG8_WAIT_L(0); PG8_BAR; PG8_MMA(0, 0, At, B0); PG8_MMA(0, 1, At, B1); PG8_BAR; PG8_SCHED;
            PG8_LDA(At, 1, 1); PG8_STAGE(PG8_SB(1, 0), b3, voffB); PG8_STAGE(PG8_SB(1, 1), b3 + hstepB, voffB); PG8_STAGE(PG8_SA(1, 0), a3, voffA);
            PG8_WAIT_V(8); PG8_WAIT_L(0); PG8_BAR; PG8_MMA(1, 0, At, B0); PG8_MMA(1, 1, At, B1); PG8_BAR; PG8_SCHED;
        }
        if constexpr (ALIGN_EPI) { if (wr == 0) PG8_BAR; }
        E(acc, cur, wr, wc, fr, fq);
        if (!has_next) break;
#pragma unroll
        for (int a = 0; a < 2; ++a)
#pragma unroll
            for (int b = 0; b < 2; ++b)
#pragma unroll
                for (int m = 0; m < 4; ++m)
#pragma unroll
                    for (int n = 0; n < 2; ++n) acc[a][b][m][n] = (f32x4){0.f, 0.f, 0.f, 0.f};
        cur = nxt; cA = nA; cB = nB; ++ui;
        if constexpr (ALIGN_EPI) { if (wr == 1) PG8_BAR; }
    }
    PG8_WAIT_V(0);
    if constexpr (!ALIGN_EPI) { if (wr == 0) PG8_BAR; }
    PG8_BAR;
#undef PG8_SA
#undef PG8_SB
#undef PG8_STAGE
#undef PG8_LDA
#undef PG8_LDB
#undef PG8_MMA
#undef PG8_WAIT_V
#undef PG8_WAIT_L
#undef PG8_BAR
#undef PG8_SCHED
}
}

__device__ __forceinline__ int win_src_col(int n) {
    if (n < 1024) { const int m = n & 63; if (m < 16) { const int i = m >> 1; return (n & ~63) + ((m & 1) ? i + 8 : i); } return n; }
    if (n >= 1536 && n < 2560) { const int m = n & 63, i = m >> 1; return (n & ~63) + ((m & 1) ? i + 32 : i); }
    return n;
}
template <bool MAP> __device__ __forceinline__ void transpose_item(const float* W, int K, int N, const float* gain, bf16_t* WT, LAS float* scr, int item, int lane) {
    const int nblk = N / 32, kb = item / nblk, nb = item % nblk, k0 = 64 * kb, n0 = 32 * nb;
    const int nd = n0 + (lane & 31); const int ns = MAP ? win_src_col(nd) : nd;
#pragma unroll 8
    for (int i = 0; i < 32; ++i) { const int kk = 2 * i + (lane >> 5); float v = W[(size_t)(k0 + kk) * N + ns]; if (gain) v *= gain[k0 + kk]; scr[kk * 33 + (lane & 31)] = v; }
    asm volatile("s_waitcnt lgkmcnt(0)" ::: "memory");
    const int c = lane & 7;
#pragma unroll
    for (int j = 0; j < 4; ++j) { const int n = (lane >> 3) + 8 * j; const LAS float* s = scr + (8 * c) * 33 + n;
        u32x4 o; o.x = cvt_pk_bf16(s[0 * 33], s[1 * 33]); o.y = cvt_pk_bf16(s[2 * 33], s[3 * 33]); o.z = cvt_pk_bf16(s[4 * 33], s[5 * 33]); o.w = cvt_pk_bf16(s[6 * 33], s[7 * 33]);
        *(u32x4*)(WT + (size_t)(n0 + n) * K + k0 + 8 * c) = o; }
    asm volatile("s_waitcnt lgkmcnt(0)" ::: "memory");
}

struct Args { const float* in[16]; float* out; unsigned char* ws; };
typedef const __attribute__((address_space(4))) Args* KArgs;
#define KA() ({ KArgs p_ = (KArgs)__builtin_amdgcn_kernarg_segment_ptr(); asm volatile("" : "+s"(p_)); p_; })
#define WSP(off) (KA()->ws + (off))

__device__ __forceinline__ void convert_layer(KArgs a, int layer, LAS unsigned char* lds, int wid, int lane) {
    LAS float* scr = (LAS float*)(lds + wid * 8448);
    bf16_t* WB = (bf16_t*)(a->ws + WS_WB);
    const int gw = blockIdx.x * 8 + wid, NGW = gridDim.x * 8;
    constexpr int I_IN = 16 * 208, I_AO = 8 * 32, I_RO = 16 * 32, I_WO = 16 * 32, I_UP = 16 * 128, I_DN = 64 * 32, I_PG = 16 * 32, I_PP = 4 * 32;
    constexpr int NITEMS = I_IN + I_AO + I_RO + I_WO + I_UP + I_DN + I_PG + I_PP;
    for (int it = gw; it < NITEMS; it += NGW) {
        int r = it;
        if (r < I_IN) { transpose_item<true>(a->in[2] + (size_t)layer * 1024 * 6656, 1024, 6656, a->in[11] + layer * 1024, WB + WB_IN, scr, r, lane); continue; } r -= I_IN;
        if (r < I_AO) { transpose_item<false>(a->in[3] + (size_t)layer * 512 * 1024, 512, 1024, nullptr, WB + WB_AO, scr, r, lane); continue; } r -= I_AO;
        if (r < I_RO) { transpose_item<false>(a->in[4] + (size_t)layer * 1024 * 1024, 1024, 1024, nullptr, WB + WB_RO, scr, r, lane); continue; } r -= I_RO;
        if (r < I_WO) { transpose_item<false>(a->in[5] + (size_t)layer * 1024 * 1024, 1024, 1024, nullptr, WB + WB_WO, scr, r, lane); continue; } r -= I_WO;
        if (r < I_UP) { transpose_item<false>(a->in[6] + (size_t)layer * 1024 * 4096, 1024, 4096, a->in[13] + layer * 1024, WB + WB_UP, scr, r, lane); continue; } r -= I_UP;
        if (r < I_DN) { transpose_item<false>(a->in[7] + (size_t)layer * 4096 * 1024, 4096, 1024, nullptr, WB + WB_DN, scr, r, lane); continue; } r -= I_DN;
        if (r < I_PG) { transpose_item<false>(a->in[8] + (size_t)layer * 1024 * 1024, 1024, 1024, nullptr, WB + WB_PG, scr, r, lane); continue; } r -= I_PG;
        transpose_item<false>(a->in[9] + (size_t)layer * 256 * 1024, 256, 1024, nullptr, WB + WB_PP, scr, r, lane);
    }
    const f32x4* ps = (const f32x4*)(a->in[1] + (size_t)layer * M * PLE); u32x4* pd = (u32x4*)(a->ws + WS_PB);
    const int gt = blockIdx.x * 512 + threadIdx.x, NT = gridDim.x * 512;
    for (int i = gt; i < M * PLE / 8; i += NT) { const f32x4 x0 = ps[2 * i], x1 = ps[2 * i + 1];
        u32x4 w; w.x = cvt_pk_bf16(x0[0], x0[1]); w.y = cvt_pk_bf16(x0[2], x0[3]); w.z = cvt_pk_bf16(x1[0], x1[1]); w.w = cvt_pk_bf16(x1[2], x1[3]); pd[i] = w; }
}

__device__ __forceinline__ void sincos_acc(float xf, float& c, float& s) {
    const double x = (double)xf; const double k = rint(x * 0.15915494309189535);
    double r = fma(-k, 6.283185307179586, x); r = fma(-k, 2.4492935982947064e-16, r);
    const double r2 = r * r;
    double sp = 1.0, cp = 1.0;
#pragma unroll
    for (int i = 13; i >= 1; --i) { sp = 1.0 - sp * r2 / (double)((2 * i) * (2 * i + 1)); cp = 1.0 - cp * r2 / (double)((2 * i - 1) * (2 * i)); }
    s = (float)(r * sp); c = (float)cp;
}
__device__ __forceinline__ void build_tables(KArgs a) {
    f32x2* tabA = (f32x2*)(a->ws + WS_TABA); f32x2* tabR = (f32x2*)(a->ws + WS_TABR);
    const int gt = blockIdx.x * 512 + threadIdx.x, NT = gridDim.x * 512;
    for (int e = gt; e < 4096 * 40; e += NT) {
        const int pos = e / 40, j = e % 40; float inv;
        if (j < 8) inv = (float)exp2(-(double)j * 0.125 * 18.931568569324174);
        else inv = (float)exp2(-(double)(j - 8) * 0.03125 * 13.287712379549449);
        const float ang = (float)pos * inv; float c, s; sincos_acc(ang, c, s);
        if (j < 8) tabA[pos * 8 + j] = (f32x2){c, s}; else tabR[pos * 32 + (j - 8)] = (f32x2){c, s};
    }
}

__device__ __forceinline__ void row_pass(const float* hsrc, float* hout, const bf16_t* Y, int ldy, const float* part, const float* gain, const bf16_t* G, int ldg,
                                         bf16_t* hb, float* rs, int wid, int lane) {
    const int gw = blockIdx.x * 8 + wid, NGW = gridDim.x * 8;
    for (int row = gw; row < M; row += NGW) {
        float rsy = 0.f;
        if (Y) { float pz = (lane < 16) ? part[(size_t)row * 16 + lane] : 0.f; pz = wave_sum(pz); rsy = 1.0f / sqrtf(pz * (1.0f / D) + NORM_EPS); }
        float ss = 0.f;
#pragma unroll
        for (int j = 0; j < 4; ++j) {
            const int col = 4 * lane + 256 * j;
            f32x4 h = *(const f32x4*)(hsrc + (size_t)row * D + col);
            if (Y) {
                const u32x2 yw = *(const u32x2*)(Y + (size_t)row * ldy + col); const f32x4 gn = *(const f32x4*)(gain + col);
                f32x4 y = (f32x4){bflo(yw.x), bfhi(yw.x), bflo(yw.y), bfhi(yw.y)};
                y = y * rsy * gn;
                if (G) { const u32x2 gw2 = *(const u32x2*)(G + (size_t)row * ldg + col); y = y * (f32x4){bflo(gw2.x), bfhi(gw2.x), bflo(gw2.y), bfhi(gw2.y)}; }
                h = h + y;
            }
            if (hout) *(f32x4*)(hout + (size_t)row * D + col) = h;
            u32x2 o; o.x = cvt_pk_bf16(h[0], h[1]); o.y = cvt_pk_bf16(h[2], h[3]); *(u32x2*)(hb + (size_t)row * D + col) = o;
            ss += (h[0] * h[0] + h[1] * h[1]) + (h[2] * h[2] + h[3] * h[3]);
        }
        ss = wave_sum(ss);
        if (lane == 0) rs[row] = 1.0f / sqrtf(ss * (1.0f / D) + NORM_EPS);
    }
}

__device__ __forceinline__ void attn_phase(LAS unsigned char* lds, bf16_t* P, int wid, int lane) {
    const int n = lane & 15, g = lane >> 4;
    LAS unsigned char* vb = lds + wid * 9216;
    const unsigned troff = (unsigned)((4 * g + ((lane & 15) >> 2)) * 144 + (lane & 3) * 8);
    for (int T = blockIdx.x * 8 + wid; T < 16384; T += gridDim.x * 8) {
        const int c = T & 15, blk = (T >> 4) & 15, bh = T >> 8, h = bh & 7, b = bh >> 3;
        const size_t rowbase = (size_t)b * SEQ;
        bf16_t* Pq = P + (rowbase + blk * 256 + c + 16 * n) * LDP + h * 64;
        const bf16x8 qf0 = *(const bf16x8*)(Pq + C_QA + 8 * g), qf1 = *(const bf16x8*)(Pq + C_QA + 32 + 8 * g);
        const bf16_t* Pb = P + rowbase * LDP + h * 64;
        bf16x8 kn[2][2]; u32x4 vn[4];
#define GRP(pi, sh, cr, kbase, iq0, iqs) int sh, cr, kbase, iq0, iqs; \
        if ((pi) < 5) { sh = 4; cr = c; kbase = blk * 16 - 64 + 32 * (pi); iq0 = blk * 16; iqs = 1; } \
        else if ((pi) < 11) { sh = 2; cr = c & 3; kbase = blk * 64 + (c >> 2) - 64 + 32 * ((pi) - 5); iq0 = blk * 64 + (c >> 2); iqs = 4; } \
        else { sh = 0; cr = 0; kbase = blk * 256 + c - 64 + 32 * ((pi) - 11); iq0 = blk * 256 + c; iqs = 16; }
#define LOADPAIR(pi) do { GRP(pi, sh_, cr_, kb_, iq0_, iqs_); (void)iq0_; (void)iqs_; const int L_ = SEQ >> sh_; \
        _Pragma("unroll") for (int t = 0; t < 2; ++t) { int ik = kb_ + 16 * t + n; ik = ik < 0 ? 0 : (ik >= L_ ? L_ - 1 : ik); const bf16_t* kp = Pb + (size_t)(cr_ + (ik << sh_)) * LDP + C_KA; \
            kn[t][0] = *(const bf16x8*)(kp + 8 * g); kn[t][1] = *(const bf16x8*)(kp + 32 + 8 * g); } \
        _Pragma("unroll") for (int x = 0; x < 4; ++x) { int ik = kb_ + (lane >> 3) + 8 * x; ik = ik < 0 ? 0 : (ik >= L_ ? L_ - 1 : ik); \
            vn[x] = *(const u32x4*)(Pb + (size_t)(cr_ + (ik << sh_)) * LDP + C_VA + (lane & 7) * 8); } } while (0)
        LOADPAIR(0);
        float mrun = -1e30f, lrun = 0.f; f32x4 ot[4];
#pragma unroll
        for (int t = 0; t < 4; ++t) ot[t] = (f32x4){0.f, 0.f, 0.f, 0.f};
        for (int pi = 0; pi < 23; ++pi) {
            bf16x8 kc[2][2]; u32x4 vc[4];
#pragma unroll
            for (int t = 0; t < 2; ++t) { kc[t][0] = kn[t][0]; kc[t][1] = kn[t][1]; }
#pragma unroll
            for (int x = 0; x < 4; ++x) vc[x] = vn[x];
            if (pi + 1 < 23) LOADPAIR(pi + 1);
            GRP(pi, sh, cr, kbase, iq0, iqs); (void)cr;
            const int L = SEQ >> sh, iqn = iq0 + iqs * n;
            LAS unsigned char* vbuf = vb + (pi & 1) * 4608;
#pragma unroll
            for (int x = 0; x < 4; ++x) *(LAS u32x4*)(vbuf + ((lane >> 3) + 8 * x) * 144 + (lane & 7) * 16) = vc[x];
            f32x4 s0 = (f32x4){0.f, 0.f, 0.f, 0.f}, s1 = (f32x4){0.f, 0.f, 0.f, 0.f};
            s0 = __builtin_amdgcn_mfma_f32_16x16x32_bf16(kc[0][0], qf0, s0, 0, 0, 0); s0 = __builtin_amdgcn_mfma_f32_16x16x32_bf16(kc[0][1], qf1, s0, 0, 0, 0);
            s1 = __builtin_amdgcn_mfma_f32_16x16x32_bf16(kc[1][0], qf0, s1, 0, 0, 0); s1 = __builtin_amdgcn_mfma_f32_16x16x32_bf16(kc[1][1], qf1, s1, 0, 0, 0);
            float tmax = -1e30f; bool ok0[4], ok1[4];
#pragma unroll
            for (int i = 0; i < 4; ++i) {
                const int ik0 = kbase + 4 * g + i, ik1 = ik0 + 16; const int d0 = iqn - ik0, d1 = iqn - ik1;
                ok0[i] = (ik0 >= 0) && (ik0 < L) && (d0 <= 64) && (d0 >= -64); ok1[i] = (ik1 >= 0) && (ik1 < L) && (d1 <= 64) && (d1 >= -64);
                if (ok0[i]) tmax = fmaxf(tmax, s0[i]); if (ok1[i]) tmax = fmaxf(tmax, s1[i]);
            }
            tmax = fmaxf(tmax, __shfl_xor(tmax, 16)); tmax = fmaxf(tmax, __shfl_xor(tmax, 32));
            const float mnew = fmaxf(mrun, tmax), alpha = __expf(mrun - mnew);
            f32x4 p0, p1; float ps = 0.f;
#pragma unroll
            for (int i = 0; i < 4; ++i) { p0[i] = ok0[i] ? __expf(s0[i] - mnew) : 0.f; p1[i] = ok1[i] ? __expf(s1[i] - mnew) : 0.f; ps += p0[i] + p1[i]; }
            lrun = lrun * alpha + ps; mrun = mnew;
#pragma unroll
            for (int t = 0; t < 4; ++t) ot[t] = ot[t] * alpha;
            const bf16x8 pf = pack8(p0, p1);
            asm volatile("" ::: "memory");
#pragma unroll
            for (int t = 0; t < 4; ++t) {
                const s16x4 lo = tr_read(vbuf + troff + t * 32), hi = tr_read(vbuf + troff + 16 * 144 + t * 32);
                ot[t] = __builtin_amdgcn_mfma_f32_16x16x32_bf16(cat8(lo, hi), pf, ot[t], 0, 0, 0);
            }
            asm volatile("" ::: "memory");
        }
#undef LOADPAIR
#undef GRP
        float l = lrun; l += __shfl_xor(l, 16); l += __shfl_xor(l, 32);
        const float inv = 1.0f / l;
#pragma unroll
        for (int t = 0; t < 4; ++t) { u32x2 o; o.x = cvt_pk_bf16(ot[t][0] * inv, ot[t][1] * inv); o.y = cvt_pk_bf16(ot[t][2] * inv, ot[t][3] * inv);
            *(u32x2*)(Pq + C_QA + 16 * t + 4 * g) = o; }
    }
}

__device__ __forceinline__ void ret_kv_phase(LAS unsigned char* lds, const bf16_t* P, bf16_t* KV, const float* dl, int tid, int wid, int lane) {
    constexpr int KF = 0, KB = 18432, VO = 36864;
    const int g = lane >> 4, li = lane & 15, trq = li >> 2, trp = li & 3;
    for (int unit = blockIdx.x; unit < 2048; unit += gridDim.x) {
        const int bh = unit >> 5, nn = unit & 31, b = bh >> 3, h = bh & 7;
        const float lgf = logsig(dl[h]), lgb = logsig(dl[8 + h]);
        const size_t row0 = (size_t)b * SEQ + nn * 128;
#pragma unroll
        for (int x = 0; x < 2; ++x) { const int q = tid + 512 * x, R = q >> 3, pc = q & 7;
            const u32x4 w = *(const u32x4*)(P + (row0 + R) * LDP + C_KR + h * 64 + pc * 8);
            const float zf = expf(lgf * (float)(127 - R)), zb = expf(lgb * (float)R);
            *(LAS u32x4*)(lds + KF + R * 144 + pc * 16) = scale8(w, zf); *(LAS u32x4*)(lds + KB + R * 144 + pc * 16) = scale8(w, zb); }
#pragma unroll
        for (int x = 0; x < 4; ++x) { const int q = tid + 512 * x, R = q >> 4, pc = q & 15;
            *(LAS u32x4*)(lds + VO + R * 272 + pc * 16) = *(const u32x4*)(P + (row0 + R) * LDP + C_VR + h * 128 + pc * 8); }
        __syncthreads();
        f32x4 acc[8];
#pragma unroll
        for (int i = 0; i < 8; ++i) acc[i] = (f32x4){0.f, 0.f, 0.f, 0.f};
#pragma unroll
        for (int ks = 0; ks < 4; ++ks) {
            const int tr0 = 32 * ks + 8 * g + trq;
            const bf16x8 af = cat8(tr_read(lds + VO + tr0 * 272 + (16 * wid + 4 * trp) * 2), tr_read(lds + VO + (tr0 + 4) * 272 + (16 * wid + 4 * trp) * 2));
#pragma unroll
            for (int dkt = 0; dkt < 8; ++dkt) {
                const int ko = (dkt < 4 ? KF : KB) + (16 * (dkt & 3) + 4 * trp) * 2;
                const bf16x8 bf = cat8(tr_read(lds + ko + tr0 * 144), tr_read(lds + ko + (tr0 + 4) * 144));
                acc[dkt] = __builtin_amdgcn_mfma_f32_16x16x32_bf16(af, bf, acc[dkt], 0, 0, 0);
            }
        }
        bf16_t* KVu = KV + (size_t)unit * 16384;
#pragma unroll
        for (int dkt = 0; dkt < 8; ++dkt) { u32x2 o; o.x = cvt_pk_bf16(acc[dkt][0], acc[dkt][1]); o.y = cvt_pk_bf16(acc[dkt][2], acc[dkt][3]);
            *(u32x2*)(KVu + (dkt >> 2) * 8192 + (16 * (dkt & 3) + li) * 128 + 16 * wid + 4 * g) = o; }
        __syncthreads();
    }
}
__device__ __forceinline__ void ret_scan_phase(bf16_t* KV, const float* dl, int tid) {
    const int gt = blockIdx.x * 512 + tid, NT = gridDim.x * 512;
    for (int e = gt; e < 64 * 8192; e += NT) {
        const int bh = e >> 13, pp = e & 8191, dir = pp >> 12, h = bh & 7;
        const float G = expf(128.0f * logsig(dl[dir * 8 + h]));
        unsigned* base = (unsigned*)KV + (size_t)bh * 32 * 8192 + pp;
        float s0 = 0.f, s1 = 0.f;
#pragma unroll 8
        for (int st = 0; st < 32; ++st) { const int nn = dir ? 31 - st : st; const unsigned w = base[(size_t)nn * 8192]; base[(size_t)nn * 8192] = cvt_pk_bf16(s0, s1);
            s0 = s0 * G + bflo(w); s1 = s1 * G + bfhi(w); }
    }
}
__device__ __forceinline__ void ret_out_phase(LAS unsigned char* lds, bf16_t* P, const bf16_t* KV, const float* dl, int tid, int wid, int lane) {
    constexpr int KO = 0, VO = 18432, SF = 53248, SB = 70656;
    const int g = lane >> 4, li = lane & 15, trq = li >> 2, trp = li & 3;
    for (int unit = blockIdx.x; unit < 2048; unit += gridDim.x) {
        const int bh = unit >> 5, nn = unit & 31, b = bh >> 3, h = bh & 7;
        const float lgf = logsig(dl[h]), lgb = logsig(dl[8 + h]);
        const size_t row0 = (size_t)b * SEQ + nn * 128;
        const bf16_t* KVu = KV + (size_t)unit * 16384;
#pragma unroll
        for (int x = 0; x < 2; ++x) { const int q = tid + 512 * x, R = q >> 3, pc = q & 7;
            *(LAS u32x4*)(lds + KO + R * 144 + pc * 16) = *(const u32x4*)(P + (row0 + R) * LDP + C_KR + h * 64 + pc * 8); }
#pragma unroll
        for (int x = 0; x < 4; ++x) { const int q = tid + 512 * x, R = q >> 4, pc = q & 15;
            *(LAS u32x4*)(lds + VO + R * 272 + pc * 16) = *(const u32x4*)(P + (row0 + R) * LDP + C_VR + h * 128 + pc * 8); }
#pragma unroll
        for (int x = 0; x < 4; ++x) { const int q = tid + 512 * x, dir = q >> 10, R = (q >> 4) & 63, pc = q & 15;
            *(LAS u32x4*)(lds + (dir ? SB : SF) + R * 272 + pc * 16) = *(const u32x4*)(KVu + dir * 8192 + R * 128 + pc * 8); }
        const int a = 16 * wid + li;
        bf16_t* Pr = P + (row0 + a) * LDP;
        const u32x4 q0 = *(const u32x4*)(Pr + C_QR + h * 64 + 8 * g), q1 = *(const u32x4*)(Pr + C_QR + h * 64 + 32 + 8 * g);
        const float xf = expf(lgf * (float)(a + 1)), xb = expf(lgb * (float)(128 - a));
        const bf16x8 qr0 = __builtin_bit_cast(bf16x8, q0), qr1 = __builtin_bit_cast(bf16x8, q1);
        const bf16x8 qf0 = __builtin_bit_cast(bf16x8, scale8(q0, xf)), qf1 = __builtin_bit_cast(bf16x8, scale8(q1, xf));
        const bf16x8 qb0 = __builtin_bit_cast(bf16x8, scale8(q0, xb)), qb1 = __builtin_bit_cast(bf16x8, scale8(q1, xb));
        __syncthreads();
        bf16x8 pf[4];
#pragma unroll
        for (int kp = 0; kp < 4; ++kp) {
            f32x4 st[2];
#pragma unroll
            for (int t = 0; t < 2; ++t) {
                const int kt = 2 * kp + t;
                const bf16x8 k0 = *(const LAS bf16x8*)(lds + KO + (16 * kt + li) * 144 + 16 * g), k1 = *(const LAS bf16x8*)(lds + KO + (16 * kt + li) * 144 + 64 + 16 * g);
                f32x4 s = (f32x4){0.f, 0.f, 0.f, 0.f};
                s = __builtin_amdgcn_mfma_f32_16x16x32_bf16(k0, qr0, s, 0, 0, 0); s = __builtin_amdgcn_mfma_f32_16x16x32_bf16(k1, qr1, s, 0, 0, 0);
#pragma unroll
                for (int i = 0; i < 4; ++i) { const int key = 16 * kt + 4 * g + i, d = a - key; const float w = d >= 0 ? expf(lgf * (float)d) : expf(lgb * (float)(-d)); s[i] *= w; }
                st[t] = s;
            }
            pf[kp] = pack8(st[0], st[1]);
        }
        f32x4 acc[8];
#pragma unroll
        for (int dt = 0; dt < 8; ++dt) {
            f32x4 c = (f32x4){0.f, 0.f, 0.f, 0.f};
            const int co = (16 * dt + 4 * trp) * 2;
#pragma unroll
            for (int kp = 0; kp < 4; ++kp) {
                const bf16x8 vf = cat8(tr_read(lds + VO + (32 * kp + 4 * g + trq) * 272 + co), tr_read(lds + VO + (32 * kp + 16 + 4 * g + trq) * 272 + co));
                c = __builtin_amdgcn_mfma_f32_16x16x32_bf16(vf, pf[kp], c, 0, 0, 0);
            }
#pragma unroll
            for (int ks = 0; ks < 2; ++ks) {
                const int r0 = 32 * ks + 8 * g + trq;
                const bf16x8 sf = cat8(tr_read(lds + SF + r0 * 272 + co), tr_read(lds + SF + (r0 + 4) * 272 + co));
                c = __builtin_amdgcn_mfma_f32_16x16x32_bf16(sf, ks ? qf1 : qf0, c, 0, 0, 0);
                const bf16x8 sb = cat8(tr_read(lds + SB + r0 * 272 + co), tr_read(lds + SB + (r0 + 4) * 272 + co));
                c = __builtin_amdgcn_mfma_f32_16x16x32_bf16(sb, ks ? qb1 : qb0, c, 0, 0, 0);
            }
            acc[dt] = c;
        }
        float s = 0.f;
#pragma unroll
        for (int dt = 0; dt < 8; ++dt) s += (acc[dt][0] + acc[dt][1]) + (acc[dt][2] + acc[dt][3]);
        s += __shfl_xor(s, 16); s += __shfl_xor(s, 32);
        const float mu = s * (1.0f / 128.0f); float vq = 0.f;
#pragma unroll
        for (int dt = 0; dt < 8; ++dt) { const f32x4 d = acc[dt] - mu; vq += (d[0] * d[0] + d[1] * d[1]) + (d[2] * d[2] + d[3] * d[3]); }
        vq += __shfl_xor(vq, 16); vq += __shfl_xor(vq, 32);
        const float rstd = 1.0f / sqrtf(vq * (1.0f / 128.0f) + GN_EPS);
#pragma unroll
        for (int dt = 0; dt < 8; ++dt) {
            const int col = h * 128 + 16 * dt + 4 * g;
            const u32x2 gw = *(const u32x2*)(Pr + C_GR + col);
            const f32x4 y = (acc[dt] - mu) * rstd;
            u32x2 o; o.x = cvt_pk_bf16(y[0] * bflo(gw.x), y[1] * bfhi(gw.x)); o.y = cvt_pk_bf16(y[2] * bflo(gw.y), y[3] * bfhi(gw.y));
            *(u32x2*)(Pr + C_VR + col) = o;
        }
        __syncthreads();
    }
}


#ifndef DBG_STOP
#define DBG_STOP 0
#endif
__device__ __forceinline__ void dbg_dump(float* out, const bf16_t* s0, int ld0, int w0, const bf16_t* s1, int ld1, int w1) {
    const int gt = blockIdx.x * 512 + threadIdx.x, NT = gridDim.x * 512;
    for (int e = gt; e < M * D; e += NT) { const int row = e >> 10, c = e & 1023; float v = 0.f;
        for (int j = 0; c + 1024 * j < w0; ++j) v += bflo((unsigned)s0[(size_t)row * ld0 + c + 1024 * j]);
        if (s1) for (int j = 0; c + 1024 * j < w1; ++j) v += bflo((unsigned)s1[(size_t)row * ld1 + c + 1024 * j]);
        out[e] = v; }
}
#define DBG(k, s0, ld0, w0, s1, ld1, w1) do { if (DBG_STOP == (k) && layer == 0) { dbg_dump(hout, s0, ld0, w0, s1, ld1, w1); return; } } while (0)
#define DBGRET(k) do { if (DBG_STOP == (k) && layer == 0) return; } while (0)
#define GRID_SYNC() do { asm volatile("s_waitcnt vmcnt(0) lgkmcnt(0)" ::: "memory"); __syncthreads(); ++bar_gen; \
    if (threadIdx.x == 0) { __builtin_amdgcn_fence(__ATOMIC_RELEASE, "agent"); asm volatile("s_waitcnt vmcnt(0)" ::: "memory"); \
        unsigned* bw_ = (unsigned*)WSP(WS_CTL); __hip_atomic_fetch_add(bw_, 1u, __ATOMIC_RELAXED, __HIP_MEMORY_SCOPE_AGENT); const unsigned tgt_ = bar_gen * gridDim.x; \
        while (__hip_atomic_load(bw_, __ATOMIC_RELAXED, __HIP_MEMORY_SCOPE_AGENT) < tgt_) __builtin_amdgcn_s_sleep(2); } \
    __syncthreads(); __builtin_amdgcn_fence(__ATOMIC_ACQUIRE, "agent"); asm volatile("s_waitcnt vmcnt(0)" ::: "memory"); } while (0)
__global__ void __launch_bounds__(512, 2) fwd_kernel(Args a) {
    extern __shared__ __attribute__((aligned(16))) unsigned char lds_raw[];
    LAS unsigned char* lds = (LAS unsigned char*)lds_raw;
    cg::grid_group grid = cg::this_grid();
    unsigned bar_gen = 0;
    grid.sync();
    const int G = gridDim.x, cb = blockIdx.x;
#define WB ((bf16_t*)WSP(WS_WB))
#define tabA ((const f32x2*)WSP(WS_TABA))
#define tabR ((const f32x2*)WSP(WS_TABR))
#define rs ((float*)WSP(WS_RS))
#define part ((float*)WSP(WS_PART))
#define hb ((bf16_t*)WSP(WS_HB))
#define pb ((bf16_t*)WSP(WS_PB))
#define KV ((bf16_t*)WSP(WS_KV))
#define P ((bf16_t*)WSP(WS_PROJ))
#define hout (KA()->out)

#ifndef PHM
#define PHM 0xffff
#endif
    { const int tid = threadIdx.x, wid = __builtin_amdgcn_readfirstlane(tid >> 6), lane = tid & 63; (void)tid;
    if (PHM & 1) build_tables(KA());
    if (PHM & 2) convert_layer(KA(), 0, lds, wid, lane);
    if (PHM & 4) row_pass(KA()->in[0], nullptr, nullptr, 0, nullptr, nullptr, nullptr, 0, hb, rs, wid, lane); }
    GRID_SYNC();

#pragma unroll 1
    for (int layer = 0; layer < DEPTH; ++layer) {
        const float* dl = KA()->in[10] + layer * 16;
        int tid = threadIdx.x; asm volatile("" : "+v"(tid));
        const int wid = __builtin_amdgcn_readfirstlane(tid >> 6), lane = tid & 63;
        if (PHM & 8) { pg8::Gemm g{hb, WB + WB_IN, M, 4608, 1024, 1024, 1024}; pg8::StaticOrder S; S.init(M, 4608, G, cb);
          pg8::EpiProj E{P, rs, tabA, tabR}; pg8::gemm_phase<pg8::EpiProj>(lds, g, S, E); }
        GRID_SYNC();
        DBG(1, P, LDP, 4608, nullptr, 0, 0);
        if (PHM & 16) attn_phase(lds, P, wid, lane);
        __syncthreads();
        if (PHM & 32) ret_kv_phase(lds, P, KV, dl, tid, wid, lane);
        GRID_SYNC();
        DBG(2, P, LDP, 512, KV, 1024, 1024);
        if (PHM & 64) ret_scan_phase(KV, dl, tid);
        GRID_SYNC();
        DBG(3, KV, 1024, 1024, nullptr, 0, 0);
        if (PHM & 128) ret_out_phase(lds, P, KV, dl, tid, wid, lane);
        GRID_SYNC();
        DBG(4, P + C_VR, LDP, 1024, nullptr, 0, 0);
        if (PHM & 256) { pg8::StaticOrder S; S.init(M, 1024, G, cb);
          { pg8::Gemm g{hb, WB + WB_GA, M, 1024, 1024, 1024, 1024}; pg8::EpiAct<0> E{P + C_S1, LDP, rs}; pg8::gemm_phase<pg8::EpiAct<0>>(lds, g, S, E); }
          { pg8::Gemm g{P + C_QA, WB + WB_AO, M, 1024, 512, LDP, 512}; pg8::EpiMulAdd E{P + C_S1, nullptr, LDP}; pg8::gemm_phase<pg8::EpiMulAdd>(lds, g, S, E); }
          { pg8::Gemm g{hb, WB + WB_GB, M, 1024, 1024, 1024, 1024}; pg8::EpiAct<0> E{P + C_S2, LDP, rs}; pg8::gemm_phase<pg8::EpiAct<0>>(lds, g, S, E); }
          { pg8::Gemm g{P + C_VR, WB + WB_RO, M, 1024, 1024, LDP, 1024}; pg8::EpiMulAdd E{P + C_S2, P + C_S1, LDP}; pg8::gemm_phase<pg8::EpiMulAdd>(lds, g, S, E); } }
        GRID_SYNC();
        DBG(5, P + C_S2, LDP, 1024, nullptr, 0, 0);
        if (PHM & 512) { pg8::Gemm g{P + C_S2, WB + WB_WO, M, 1024, 1024, LDP, 1024}; pg8::StaticOrder S; S.init(M, 1024, G, cb);
          pg8::EpiY E{P + C_Y, LDP, part}; pg8::gemm_phase<pg8::EpiY>(lds, g, S, E); }
        GRID_SYNC();
        DBG(6, P + C_Y, LDP, 1024, nullptr, 0, 0);
        row_pass(layer == 0 ? KA()->in[0] : hout, hout, P + C_Y, LDP, part, KA()->in[12] + layer * D, nullptr, 0, hb, rs, wid, lane);
        GRID_SYNC();
        DBGRET(7);
        if (PHM & 1024) { pg8::Gemm g{hb, WB + WB_UP, M, FF, 1024, 1024, 1024}; pg8::StaticOrder S; S.init(M, FF, G, cb);
          pg8::EpiAct<1> E{P, FF, rs}; pg8::gemm_phase<pg8::EpiAct<1>>(lds, g, S, E); }
        GRID_SYNC();
        DBG(8, P, FF, 4096, nullptr, 0, 0);
        if (PHM & 2048) { pg8::Gemm g{P, WB + WB_DN, M, 1024, FF, FF, FF}; pg8::StaticOrder S; S.init(M, 1024, G, cb);
          pg8::EpiY E{KV, 1024, part}; pg8::gemm_phase<pg8::EpiY>(lds, g, S, E); }
        GRID_SYNC();
        DBG(9, KV, 1024, 1024, nullptr, 0, 0);
        row_pass(hout, hout, KV, 1024, part, KA()->in[14] + layer * D, nullptr, 0, hb, rs, wid, lane);
        GRID_SYNC();
        DBGRET(10);
        if (PHM & 4096) { pg8::StaticOrder S; S.init(M, 1024, G, cb);
          { pg8::Gemm g{hb, WB + WB_PG, M, 1024, 1024, 1024, 1024}; pg8::EpiAct<0> E{P, 1024, rs}; pg8::gemm_phase<pg8::EpiAct<0>>(lds, g, S, E); }
          { pg8::Gemm g{pb, WB + WB_PP, M, 1024, PLE, PLE, PLE}; pg8::EpiY E{KV, 1024, part}; pg8::gemm_phase<pg8::EpiY>(lds, g, S, E); } }
        GRID_SYNC();
        DBG(11, P, 1024, 1024, KV, 1024, 1024);
        row_pass(hout, hout, KV, 1024, part, KA()->in[15] + layer * D, P, 1024, hb, rs, wid, lane);
        if (layer + 1 < DEPTH) convert_layer(KA(), layer + 1, lds, wid, lane);
        GRID_SYNC();
        DBGRET(12);
    }
}
#undef WB
#undef tabA
#undef tabR
#undef rs
#undef part
#undef hb
#undef pb
#undef KV
#undef P
#undef hout

extern "C" void kernel_launch(void* const* d_in, const int* in_sizes, int n_in, void* d_out, int out_size, void* d_ws, size_t ws_size, hipStream_t stream) {
    static int grid = 0;
    if (grid == 0) {
        if (n_in != 16 || out_size != M * D || ws_size < WS_END) { fprintf(stderr, "kernel_launch: unexpected shapes/workspace (n_in %d out %d ws %zu)\n", n_in, out_size, ws_size); grid = -1; return; }
        int dev = 0, cus = 0, per_cu = 0;
        hipGetDevice(&dev); hipDeviceGetAttribute(&cus, hipDeviceAttributeMultiprocessorCount, dev);
        hipFuncSetAttribute((const void*)fwd_kernel, hipFuncAttributeMaxDynamicSharedMemorySize, LDS_BYTES);
        hipOccupancyMaxActiveBlocksPerMultiprocessor(&per_cu, (const void*)fwd_kernel, 512, LDS_BYTES);
        if (per_cu < 1) per_cu = 1;
        grid = cus * 1;
        (void)hipGetLastError();
    }
    if (grid < 0) return;
    if (hipMemsetAsync((char*)d_ws + WS_CTL, 0, 256, stream) != hipSuccess) { fprintf(stderr, "memset failed\n"); return; }
    Args a{};
    for (int i = 0; i < 16; ++i) a.in[i] = (const float*)d_in[i];
    a.out = (float*)d_out; a.ws = (unsigned char*)d_ws;
    void* args[] = {&a};
    hipError_t e = hipLaunchCooperativeKernel((const void*)fwd_kernel, dim3(grid), dim3(512), args, LDS_BYTES, stream);
    if (e != hipSuccess) fprintf(stderr, "cooperative launch failed: %s (grid %d)\n", hipGetErrorString(e), grid);
}
```

```cpp
#include <hip/hip_runtime.h>
#include <hip/hip_cooperative_groups.h>
#include <cstdio>
#include <cstdint>
namespace cg = cooperative_groups;

#define LAS __attribute__((address_space(3)))
typedef unsigned short bf16_t;
typedef short bf16x8 __attribute__((ext_vector_type(8)));
typedef short s16x4 __attribute__((ext_vector_type(4)));
typedef short v4i16_t __attribute__((ext_vector_type(4)));
typedef float f32x4 __attribute__((ext_vector_type(4)));
typedef float f32x2 __attribute__((ext_vector_type(2)));
typedef unsigned u32x4 __attribute__((ext_vector_type(4)));
typedef unsigned u32x2 __attribute__((ext_vector_type(2)));

constexpr int M = 32768, D = 1024, SEQ = 4096, DEPTH = 4, FF = 4096, PLE = 256;
constexpr int LDP = 4608;
constexpr int C_QA = 0, C_KA = 512, C_VA = 1024, C_QR = 1536, C_KR = 2048, C_VR = 2560, C_GR = 3584;
constexpr int C_S1 = 512, C_S2 = 1536, C_Y = 3584;
constexpr float NORM_EPS = 1e-6f, GN_EPS = 1e-5f;
constexpr size_t MiB = 1u << 20;
constexpr size_t WS_WB = 0;
constexpr size_t WB_IN = 0, WB_GA = (size_t)4608 * 1024, WB_GB = (size_t)5632 * 1024, WB_AO = (size_t)6656 * 1024, WB_RO = WB_AO + 1024 * 512,
                 WB_WO = WB_RO + 1024 * 1024, WB_UP = WB_WO + 1024 * 1024, WB_DN = WB_UP + 4096 * 1024, WB_PG = WB_DN + 4096 * 1024, WB_PP = WB_PG + 1024 * 1024;
constexpr size_t WS_TABA = 37 * MiB, WS_TABR = WS_TABA + 4096 * 8 * 8;
constexpr size_t WS_CTL = 38 * MiB + 512 * 1024;
constexpr size_t WS_RS = 39 * MiB, WS_PART = 40 * MiB;
constexpr size_t WS_HB = 42 * MiB, WS_PB = 106 * MiB, WS_KV = 122 * MiB, WS_PROJ = 186 * MiB, WS_END = 474 * MiB;
constexpr int LDS_BYTES = 147456;

typedef __bf16 bf16x2_t __attribute__((ext_vector_type(2)));
__device__ __forceinline__ unsigned cvt_pk_bf16(float lo, float hi) { const f32x2 v = {lo, hi}; const bf16x2_t b = __builtin_convertvector(v, bf16x2_t); return __builtin_bit_cast(unsigned, b); }
__device__ __forceinline__ float bflo(unsigned w) { return __uint_as_float(w << 16); }
__device__ __forceinline__ float bfhi(unsigned w) { return __uint_as_float(w & 0xffff0000u); }
__device__ __forceinline__ float sigmoidf_(float x) { return __builtin_amdgcn_rcpf(1.0f + __expf(-x)); }
__device__ __forceinline__ float wave_sum(float v) {
#pragma unroll
    for (int o = 1; o < 64; o <<= 1) v += __shfl_xor(v, o);
    return v;
}
__device__ __forceinline__ float logsig(float x) { return -log1pf(expf(-x)); }
__device__ __forceinline__ s16x4 tr_read(LAS unsigned char* p) { return __builtin_bit_cast(s16x4, __builtin_amdgcn_ds_read_tr16_b64_v4i16((LAS v4i16_t*)p)); }
__device__ __forceinline__ bf16x8 cat8(s16x4 lo, s16x4 hi) { return (bf16x8){lo[0], lo[1], lo[2], lo[3], hi[0], hi[1], hi[2], hi[3]}; }
__device__ __forceinline__ bf16x8 pack8(f32x4 a, f32x4 b) { u32x4 w; w.x = cvt_pk_bf16(a[0], a[1]); w.y = cvt_pk_bf16(a[2], a[3]); w.z = cvt_pk_bf16(b[0], b[1]); w.w = cvt_pk_bf16(b[2], b[3]); return __builtin_bit_cast(bf16x8, w); }
__device__ __forceinline__ u32x4 scale8(u32x4 w, float s) {
    u32x4 o; o.x = cvt_pk_bf16(bflo(w.x) * s, bfhi(w.x) * s); o.y = cvt_pk_bf16(bflo(w.y) * s, bfhi(w.y) * s);
    o.z = cvt_pk_bf16(bflo(w.z) * s, bfhi(w.z) * s); o.w = cvt_pk_bf16(bflo(w.w) * s, bfhi(w.w) * s); return o;
}

namespace pg8 {
constexpr int BM = 256, BK = 64, HALF = 128, HTB = HALF * BK * 2, STAGE_BYTES = 8 * HTB, NXCD = 8, WGM = 8;
__host__ __device__ __forceinline__ int lds_byte(int r, int c) { const int st = (r >> 4) * 2 + (c >> 5), rr = r & 15, cc = c & 31, ob = rr * 64 + cc * 2; return st * 1024 + (ob ^ (((ob >> 9) & 1) << 5)); }
__host__ __device__ __forceinline__ void stage_rc(int b, int& R, int& C) { const int st = b / 1024, sb = b % 1024, swz = sb ^ (((sb >> 9) & 1) << 5); R = (st >> 1) * 16 + swz / 64; C = (st & 1) * 32 + (swz % 64) / 2; }
__host__ __device__ __forceinline__ int perm32(int rho) { const int n = rho >> 4, i = rho & 15; return 8 * (i >> 2) + 4 * n + (i & 3); }
struct Unit { int pm, pn; };
struct Gemm { const bf16_t* A; const bf16_t* Bt; int M, N, K, lda, ldb; };
struct StaticOrder {
    int nM, nN, nwg, G, c;
    __device__ void init(int M_, int N_, int G_, int c_) { nM = M_ / BM; nN = N_ / BM; nwg = nM * nN; G = G_; c = c_; }
    __device__ bool next(int i, Unit& u) const {
        const long L = (long)i * G + c; if (L >= nwg) return false;
        int wgid = (int)L; { const int q = nwg / NXCD, r = nwg % NXCD, xcd = wgid % NXCD, off = wgid / NXCD; wgid = (xcd < r ? xcd * (q + 1) : r * (q + 1) + (xcd - r) * q) + off; }
        const int nig = WGM * nN, gid = wgid / nig, fm = gid * WGM, gsz = (nM - fm) < WGM ? (nM - fm) : WGM;
        u.pm = fm + ((wgid % nig) % gsz); u.pn = (wgid % nig) / gsz; return true;
    }
};
#define EPI_ARGS const f32x4 (&acc)[2][2][4][2], const Unit& u, int wr, int wc, int fr, int fq

struct EpiProj {
    static constexpr bool PERM = true;
    bf16_t* O; const float* rs; const f32x2* tabA; const f32x2* tabR;
    __device__ __forceinline__ void operator()(EPI_ARGS) const {
        const int pn = u.pn; int kind = 0; float sc = 1.f;
        if (pn < 2) { kind = 1; sc = 0.125f; } else if (pn < 4) kind = 1; else if (pn < 6) kind = 0; else if (pn < 8) kind = 2; else if (pn < 10) { kind = 2; sc = 0.125f; } else if (pn < 14) kind = 0; else kind = 3;
        const int row0 = u.pm * BM + wr * 64 + fr, colb = pn * BM + wc * 32 + 8 * fq;
#pragma unroll
        for (int ai = 0; ai < 2; ++ai)
#pragma unroll
            for (int m = 0; m < 4; ++m) {
                const int row = row0 + ai * HALF + m * 16; const float r = rs[row] * sc; const int pos = row & (SEQ - 1);
#pragma unroll
                for (int bj = 0; bj < 2; ++bj) {
                    const int c0 = colb + bj * HALF; f32x4 v0 = acc[ai][bj][m][0] * r, v1 = acc[ai][bj][m][1] * r;
                    if (kind == 1 || kind == 2) {
                        const int cm = c0 & 63;
                        if (kind == 2 || cm < 16) {
                            const f32x4* t = (kind == 1) ? (const f32x4*)(tabA + pos * 8 + (cm >> 1)) : (const f32x4*)(tabR + pos * 32 + (cm >> 1));
                            const f32x4 t0 = t[0], t1 = t[1];
                            f32x4 w0, w1;
                            w0[0] = v0[0] * t0[0] - v0[1] * t0[1]; w0[1] = v0[1] * t0[0] + v0[0] * t0[1]; w0[2] = v0[2] * t0[2] - v0[3] * t0[3]; w0[3] = v0[3] * t0[2] + v0[2] * t0[3];
                            w1[0] = v1[0] * t1[0] - v1[1] * t1[1]; w1[1] = v1[1] * t1[0] + v1[0] * t1[1]; w1[2] = v1[2] * t1[2] - v1[3] * t1[3]; w1[3] = v1[3] * t1[2] + v1[2] * t1[3];
                            v0 = w0; v1 = w1;
                        }
                    } else if (kind == 3) {
#pragma unroll
                        for (int j = 0; j < 4; ++j) { v0[j] = v0[j] * sigmoidf_(v0[j]); v1[j] = v1[j] * sigmoidf_(v1[j]); }
                    }
                    u32x4 w; w.x = cvt_pk_bf16(v0[0], v0[1]); w.y = cvt_pk_bf16(v0[2], v0[3]); w.z = cvt_pk_bf16(v1[0], v1[1]); w.w = cvt_pk_bf16(v1[2], v1[3]);
                    *(u32x4*)(O + (size_t)row * LDP + c0) = w;
                }
            }
    }
};
template <int ACT> struct EpiAct {
    static constexpr bool PERM = true;
    bf16_t* O; int ldc; const float* rs;
    __device__ __forceinline__ void operator()(EPI_ARGS) const {
        const int row0 = u.pm * BM + wr * 64 + fr, colb = u.pn * BM + wc * 32 + 8 * fq;
#pragma unroll
        for (int ai = 0; ai < 2; ++ai)
#pragma unroll
            for (int m = 0; m < 4; ++m) {
                const int row = row0 + ai * HALF + m * 16; const float r = rs[row];
#pragma unroll
                for (int bj = 0; bj < 2; ++bj) {
                    f32x4 v0 = acc[ai][bj][m][0] * r, v1 = acc[ai][bj][m][1] * r;
#pragma unroll
                    for (int j = 0; j < 4; ++j) {
                        if (ACT == 0) { v0[j] = sigmoidf_(v0[j]); v1[j] = sigmoidf_(v1[j]); }
                        else { const float a0 = fmaxf(v0[j], 0.f), a1 = fmaxf(v1[j], 0.f); v0[j] = a0 * a0; v1[j] = a1 * a1; }
                    }
                    u32x4 w; w.x = cvt_pk_bf16(v0[0], v0[1]); w.y = cvt_pk_bf16(v0[2], v0[3]); w.z = cvt_pk_bf16(v1[0], v1[1]); w.w = cvt_pk_bf16(v1[2], v1[3]);
                    *(u32x4*)(O + (size_t)row * ldc + colb + bj * HALF) = w;
                }
            }
    }
};
struct EpiMulAdd {
    static constexpr bool PERM = true;
    bf16_t* S; const bf16_t* T; int ld;
    __device__ __forceinline__ void operator()(EPI_ARGS) const {
        const int row0 = u.pm * BM + wr * 64 + fr, colb = u.pn * BM + wc * 32 + 8 * fq;
#pragma unroll
        for (int ai = 0; ai < 2; ++ai)
#pragma unroll
            for (int m = 0; m < 4; ++m) {
                const int row = row0 + ai * HALF + m * 16;
#pragma unroll
                for (int bj = 0; bj < 2; ++bj) {
                    const size_t off = (size_t)row * ld + colb + bj * HALF;
                    const u32x4 s = *(const u32x4*)(S + off); u32x4 t = (u32x4){0u, 0u, 0u, 0u}; if (T) t = *(const u32x4*)(T + off);
                    const f32x4 a0 = acc[ai][bj][m][0], a1 = acc[ai][bj][m][1];
                    u32x4 w;
                    w.x = cvt_pk_bf16(bflo(t.x) + bflo(s.x) * a0[0], bfhi(t.x) + bfhi(s.x) * a0[1]); w.y = cvt_pk_bf16(bflo(t.y) + bflo(s.y) * a0[2], bfhi(t.y) + bfhi(s.y) * a0[3]);
                    w.z = cvt_pk_bf16(bflo(t.z) + bflo(s.z) * a1[0], bfhi(t.z) + bfhi(s.z) * a1[1]); w.w = cvt_pk_bf16(bflo(t.w) + bflo(s.w) * a1[2], bfhi(t.w) + bfhi(s.w) * a1[3]);
                    *(u32x4*)(S + off) = w;
                }
            }
    }
};
struct EpiY {
    static constexpr bool PERM = true;
    bf16_t* Y; int ldc; float* part;
    __device__ __forceinline__ void operator()(EPI_ARGS) const {
        const int row0 = u.pm * BM + wr * 64 + fr, colb = u.pn * BM + wc * 32 + 8 * fq;
#pragma unroll
        for (int ai = 0; ai < 2; ++ai)
#pragma unroll
            for (int m = 0; m < 4; ++m) {
                const int row = row0 + ai * HALF + m * 16; float s = 0.f;
#pragma unroll
                for (int bj = 0; bj < 2; ++bj) {
                    const f32x4 v0 = acc[ai][bj][m][0], v1 = acc[ai][bj][m][1];
                    s += (v0[0] * v0[0] + v0[1] * v0[1]) + (v0[2] * v0[2] + v0[3] * v0[3]) + (v1[0] * v1[0] + v1[1] * v1[1]) + (v1[2] * v1[2] + v1[3] * v1[3]);
                    u32x4 w; w.x = cvt_pk_bf16(v0[0], v0[1]); w.y = cvt_pk_bf16(v0[2], v0[3]); w.z = cvt_pk_bf16(v1[0], v1[1]); w.w = cvt_pk_bf16(v1[2], v1[3]);
                    *(u32x4*)(Y + (size_t)row * ldc + colb + bj * HALF) = w;
                }
                s += __shfl_xor(s, 16); s += __shfl_xor(s, 32);
                if (fq == 0) part[(size_t)row * 16 + u.pn * 4 + wc] = s;
            }
    }
};

template <class Epi, bool ALIGN_EPI = true>
__device__ __forceinline__ void gemm_phase(LAS unsigned char* lds, const Gemm g, const StaticOrder& S, const Epi& E) {
    int tid_ = threadIdx.x; asm volatile("" : "+v"(tid_));
    const int tid = tid_, wid = __builtin_amdgcn_readfirstlane(tid >> 6), lane = tid & 63, wr = wid >> 2, wc = wid & 3, fr = lane & 15, fq = lane >> 4;
    const int K = g.K, nt = K / BK;
    unsigned voffA[2], voffB[2];
#pragma unroll
    for (int i = 0; i < 2; ++i) { int R, C; stage_rc(tid * 16 + i * 8192, R, C); const int Rb = Epi::PERM ? ((R & ~31) + perm32(R & 31)) : R;
        voffA[i] = (unsigned)(R * g.lda + C) * 2u; voffB[i] = (unsigned)(Rb * g.ldb + C) * 2u; }
    const size_t kstep = (size_t)(BK * 2);
    const size_t hstepA = (size_t)HALF * g.lda * 2, hstepB = (size_t)HALF * g.ldb * 2;
    const size_t tstepA = 2 * hstepA, tstepB = 2 * hstepB;
    const unsigned ldsw = (unsigned)wid * 1024u;
    const int aoff = lds_byte(wr * 64 + fr, fq * 8), boff = lds_byte(wc * 32 + fr, fq * 8);
#define PG8_SA(b, h) (((b) * 2 + (h)) * HTB)
#define PG8_SB(b, h) ((4 + (b) * 2 + (h)) * HTB)
#define PG8_STAGE(bufoff, gbase, voff) do { _Pragma("unroll") for (int _i = 0; _i < 2; ++_i) \
        __builtin_amdgcn_global_load_lds((const unsigned*)((const char*)(gbase) + (voff)[_i]), (LAS unsigned*)(lds + (bufoff) + ldsw + _i * 8192), 16, 0, 0); } while (0)
#define PG8_LDA(dst, b, h) do { _Pragma("unroll") for (int m = 0; m < 4; ++m) _Pragma("unroll") for (int k = 0; k < 2; ++k) dst[m][k] = *(const LAS bf16x8*)(lds + PG8_SA(b, h) + aoff + m * 2048 + k * 1024); } while (0)
#define PG8_LDB(dst, b, h) do { _Pragma("unroll") for (int n = 0; n < 2; ++n) _Pragma("unroll") for (int k = 0; k < 2; ++k) dst[n][k] = *(const LAS bf16x8*)(lds + PG8_SB(b, h) + boff + n * 2048 + k * 1024); } while (0)
#define PG8_MMA(ai, bj, At, Bt) do { __builtin_amdgcn_s_setprio(1); _Pragma("unroll") for (int m = 0; m < 4; ++m) _Pragma("unroll") for (int n = 0; n < 2; ++n) _Pragma("unroll") for (int k = 0; k < 2; ++k) \
        acc[ai][bj][m][n] = __builtin_amdgcn_mfma_f32_16x16x32_bf16(Bt[n][k], At[m][k], acc[ai][bj][m][n], 0, 0, 0); __builtin_amdgcn_s_setprio(0); } while (0)
#define PG8_WAIT_V(n) asm volatile("s_waitcnt vmcnt(" #n ")" ::: "memory")
#define PG8_WAIT_L(n) asm volatile("s_waitcnt lgkmcnt(" #n ")" ::: "memory")
#define PG8_BAR __builtin_amdgcn_s_barrier()
#define PG8_SCHED __builtin_amdgcn_sched_barrier(0)
    Unit cur, nxt; int ui = 0;
    if (!S.next(0, cur)) return;
    f32x4 acc[2][2][4][2];
#pragma unroll
    for (int a = 0; a < 2; ++a)
#pragma unroll
        for (int b = 0; b < 2; ++b)
#pragma unroll
            for (int m = 0; m < 4; ++m)
#pragma unroll
                for (int n = 0; n < 2; ++n) acc[a][b][m][n] = (f32x4){0.f, 0.f, 0.f, 0.f};
    bf16x8 At[4][2], B0[2][2], B1[2][2];
    const char* cA = (const char*)g.A + (size_t)cur.pm * tstepA; const char* cB = (const char*)g.Bt + (size_t)cur.pn * tstepB;
    PG8_STAGE(PG8_SB(0, 0), cB, voffB); PG8_STAGE(PG8_SB(0, 1), cB + hstepB, voffB); PG8_STAGE(PG8_SA(0, 0), cA, voffA); PG8_STAGE(PG8_SA(0, 1), cA + hstepA, voffA);
    if (wr == 1) PG8_BAR;
    PG8_WAIT_V(2); PG8_BAR;
    PG8_STAGE(PG8_SB(1, 0), cB + kstep, voffB); PG8_STAGE(PG8_SA(1, 0), cA + kstep, voffA); PG8_STAGE(PG8_SB(1, 1), cB + hstepB + kstep, voffB);
    PG8_WAIT_V(6); PG8_BAR;
    for (;;) {
        const bool has_next = S.next(ui + 1, nxt);
        const char* nA = has_next ? (const char*)g.A + (size_t)nxt.pm * tstepA : cA; const char* nB = has_next ? (const char*)g.Bt + (size_t)nxt.pn * tstepB : cB;
#pragma unroll 1
        for (int t = 0; t < nt; t += 2) {
            const bool last = (t == nt - 2);
            const char* a1 = cA + (size_t)(t + 1) * kstep;
            const char* a2 = last ? nA : cA + (size_t)(t + 2) * kstep; const char* b2 = last ? nB : cB + (size_t)(t + 2) * kstep;
            const char* a3 = a2 + kstep; const char* b3 = b2 + kstep;
            PG8_LDB(B0, 0, 0); PG8_LDB(B1, 0, 1); PG8_SCHED; PG8_LDA(At, 0, 0); PG8_STAGE(PG8_SA(1, 1), a1 + hstepA, voffA);
            PG8_WAIT_V(8); PG8_WAIT_L(0); PG8_BAR; PG8_MMA(0, 0, At, B0); PG8_MMA(0, 1, At, B1); PG8_BAR; PG8_SCHED;
            PG8_LDA(At, 0, 1); PG8_STAGE(PG8_SB(0, 0), b2, voffB); PG8_STAGE(PG8_SB(0, 1), b2 + hstepB, voffB); PG8_STAGE(PG8_SA(0, 0), a2, voffA);
            PG8_WAIT_V(8); PG8_WAIT_L(0); PG8_BAR; PG8_MMA(1, 0, At, B0); PG8_MMA(1, 1, At, B1); PG8_BAR; PG8_SCHED;
            PG8_LDB(B0, 1, 0); PG8_LDB(B1, 1, 1); PG8_SCHED; PG8_LDA(At, 1, 0); PG8_STAGE(PG8_SA(0, 1), a2 + hstepA, voffA);
            PG8_WAIT_V(8); PG8_WAIT_L(0); PG8_BAR; PG8_MMA(0, 0, At, B0); PG8_MMA(0, 1, At, B1); PG8_BAR; PG8_SCHED;
            PG8_LDA(At, 1, 1); PG8_STAGE(PG8_SB(1, 0), b3, voffB); PG8_STAGE(PG8_SB(1, 1), b3 + hstepB, voffB); PG8_STAGE(PG8_SA(1, 0), a3, voffA);
            PG8_WAIT_V(8); PG8_WAIT_L(0); PG8_BAR; PG8_MMA(1, 0, At, B0); PG8_MMA(1, 1, At, B1); PG8_BAR; PG8_SCHED;
        }
        if constexpr (ALIGN_EPI) { if (wr == 0) PG8_BAR; }
        E(acc, cur, wr, wc, fr, fq);
        if (!has_next) break;
#pragma unroll
        for (int a = 0; a < 2; ++a)
#pragma unroll
            for (int b = 0; b < 2; ++b)
#pragma unroll
                for (int m = 0; m < 4; ++m)
#pragma unroll
                    for (int n = 0; n < 2; ++n) acc[a][b][m][n] = (f32x4){0.f, 0.f, 0.f, 0.f};
        cur = nxt; cA = nA; cB = nB; ++ui;
        if constexpr (ALIGN_EPI) { if (wr == 1) PG8_BAR; }
    }
    PG8_WAIT_V(0);
    if constexpr (!ALIGN_EPI) { if (wr == 0) PG8_BAR; }
    PG8_BAR;
#undef PG8_SA
#undef PG8_SB
#undef PG8_STAGE
#undef PG8_LDA
#undef PG8_LDB
#undef PG8_MMA
#undef PG8_WAIT_V
#undef PG8_WAIT_L
#undef PG8_BAR
#undef PG8_SCHED
}
}

__device__ __forceinline__ int win_src_col(int n) {
    if (n < 1024) { const int m = n & 63; if (m < 16) { const int i = m >> 1; return (n & ~63) + ((m & 1) ? i + 8 : i); } return n; }
    if (n >= 1536 && n < 2560) { const int m = n & 63, i = m >> 1; return (n & ~63) + ((m & 1) ? i + 32 : i); }
    return n;
}
template <bool MAP> __device__ __forceinline__ void transpose_item(const float* W, int K, int N, const float* gain, bf16_t* WT, LAS float* scr, int item, int lane) {
    const int nblk = N / 32, kb = item / nblk, nb = item % nblk, k0 = 64 * kb, n0 = 32 * nb;
    const int nd = n0 + (lane & 31); const int ns = MAP ? win_src_col(nd) : nd;
#pragma unroll 8
    for (int i = 0; i < 32; ++i) { const int kk = 2 * i + (lane >> 5); float v = W[(size_t)(k0 + kk) * N + ns]; if (gain) v *= gain[k0 + kk]; scr[kk * 33 + (lane & 31)] = v; }
    asm volatile("s_waitcnt lgkmcnt(0)" ::: "memory");
    const int c = lane & 7;
#pragma unroll
    for (int j = 0; j < 4; ++j) { const int n = (lane >> 3) + 8 * j; const LAS float* s = scr + (8 * c) * 33 + n;
        u32x4 o; o.x = cvt_pk_bf16(s[0 * 33], s[1 * 33]); o.y = cvt_pk_bf16(s[2 * 33], s[3 * 33]); o.z = cvt_pk_bf16(s[4 * 33], s[5 * 33]); o.w = cvt_pk_bf16(s[6 * 33], s[7 * 33]);
        *(u32x4*)(WT + (size_t)(n0 + n) * K + k0 + 8 * c) = o; }
    asm volatile("s_waitcnt lgkmcnt(0)" ::: "memory");
}

struct Args { const float* in[16]; float* out; unsigned char* ws; };
typedef const __attribute__((address_space(4))) Args* KArgs;
#define KA() ({ KArgs p_ = (KArgs)__builtin_amdgcn_kernarg_segment_ptr(); asm volatile("" : "+s"(p_)); p_; })
#define WSP(off) (KA()->ws + (off))

__device__ __forceinline__ void convert_layer(KArgs a, int layer, LAS unsigned char* lds, int wid, int lane) {
    LAS float* scr = (LAS float*)(lds + wid * 8448);
    bf16_t* WB = (bf16_t*)(a->ws + WS_WB);
    const int gw = blockIdx.x * 8 + wid, NGW = gridDim.x * 8;
    constexpr int I_IN = 16 * 208, I_AO = 8 * 32, I_RO = 16 * 32, I_WO = 16 * 32, I_UP = 16 * 128, I_DN = 64 * 32, I_PG = 16 * 32, I_PP = 4 * 32;
    constexpr int NITEMS = I_IN + I_AO + I_RO + I_WO + I_UP + I_DN + I_PG + I_PP;
    for (int it = gw; it < NITEMS; it += NGW) {
        int r = it;
        if (r < I_IN) { transpose_item<true>(a->in[2] + (size_t)layer * 1024 * 6656, 1024, 6656, a->in[11] + layer * 1024, WB + WB_IN, scr, r, lane); continue; } r -= I_IN;
        if (r < I_AO) { transpose_item<false>(a->in[3] + (size_t)layer * 512 * 1024, 512, 1024, nullptr, WB + WB_AO, scr, r, lane); continue; } r -= I_AO;
        if (r < I_RO) { transpose_item<false>(a->in[4] + (size_t)layer * 1024 * 1024, 1024, 1024, nullptr, WB + WB_RO, scr, r, lane); continue; } r -= I_RO;
        if (r < I_WO) { transpose_item<false>(a->in[5] + (size_t)layer * 1024 * 1024, 1024, 1024, nullptr, WB + WB_WO, scr, r, lane); continue; } r -= I_WO;
        if (r < I_UP) { transpose_item<false>(a->in[6] + (size_t)layer * 1024 * 4096, 1024, 4096, a->in[13] + layer * 1024, WB + WB_UP, scr, r, lane); continue; } r -= I_UP;
        if (r < I_DN) { transpose_item<false>(a->in[7] + (size_t)layer * 4096 * 1024, 4096, 1024, nullptr, WB + WB_DN, scr, r, lane); continue; } r -= I_DN;
        if (r < I_PG) { transpose_item<false>(a->in[8] + (size_t)layer * 1024 * 1024, 1024, 1024, nullptr, WB + WB_PG, scr, r, lane); continue; } r -= I_PG;
        transpose_item<false>(a->in[9] + (size_t)layer * 256 * 1024, 256, 1024, nullptr, WB + WB_PP, scr, r, lane);
    }
    const f32x4* ps = (const f32x4*)(a->in[1] + (size_t)layer * M * PLE); u32x4* pd = (u32x4*)(a->ws + WS_PB);
    const int gt = blockIdx.x * 512 + threadIdx.x, NT = gridDim.x * 512;
    for (int i = gt; i < M * PLE / 8; i += NT) { const f32x4 x0 = ps[2 * i], x1 = ps[2 * i + 1];
        u32x4 w; w.x = cvt_pk_bf16(x0[0], x0[1]); w.y = cvt_pk_bf16(x0[2], x0[3]); w.z = cvt_pk_bf16(x1[0], x1[1]); w.w = cvt_pk_bf16(x1[2], x1[3]); pd[i] = w; }
}

__device__ __forceinline__ void sincos_acc(float xf, float& c, float& s) {
    const double x = (double)xf; const double k = rint(x * 0.15915494309189535);
    double r = fma(-k, 6.283185307179586, x); r = fma(-k, 2.4492935982947064e-16, r);
    const double r2 = r * r;
    double sp = 1.0, cp = 1.0;
#pragma unroll
    for (int i = 13; i >= 1; --i) { sp = 1.0 - sp * r2 / (double)((2 * i) * (2 * i + 1)); cp = 1.0 - cp * r2 / (double)((2 * i - 1) * (2 * i)); }
    s = (float)(r * sp); c = (float)cp;
}
__device__ __forceinline__ void build_tables(KArgs a) {
    f32x2* tabA = (f32x2*)(a->ws + WS_TABA); f32x2* tabR = (f32x2*)(a->ws + WS_TABR);
    const int gt = blockIdx.x * 512 + threadIdx.x, NT = gridDim.x * 512;
    for (int e = gt; e < 4096 * 40; e += NT) {
        const int pos = e / 40, j = e % 40; float inv;
        if (j < 8) inv = (float)exp2(-(double)j * 0.125 * 18.931568569324174);
        else inv = (float)exp2(-(double)(j - 8) * 0.03125 * 13.287712379549449);
        const float ang = (float)pos * inv; float c, s; sincos_acc(ang, c, s);
        if (j < 8) tabA[pos * 8 + j] = (f32x2){c, s}; else tabR[pos * 32 + (j - 8)] = (f32x2){c, s};
    }
}

__device__ __forceinline__ void row_pass(const float* hsrc, float* hout, const bf16_t* Y, int ldy, const float* part, const float* gain, const bf16_t* G, int ldg,
                                         bf16_t* hb, float* rs, int wid, int lane) {
    const int gw = blockIdx.x * 8 + wid, NGW = gridDim.x * 8;
    for (int row = gw; row < M; row += NGW) {
        float rsy = 0.f;
        if (Y) { float pz = (lane < 16) ? part[(size_t)row * 16 + lane] : 0.f; pz = wave_sum(pz); rsy = 1.0f / sqrtf(pz * (1.0f / D) + NORM_EPS); }
        float ss = 0.f;
#pragma unroll
        for (int j = 0; j < 4; ++j) {
            const int col = 4 * lane + 256 * j;
            f32x4 h = *(const f32x4*)(hsrc + (size_t)row * D + col);
            if (Y) {
                const u32x2 yw = *(const u32x2*)(Y + (size_t)row * ldy + col); const f32x4 gn = *(const f32x4*)(gain + col);
                f32x4 y = (f32x4){bflo(yw.x), bfhi(yw.x), bflo(yw.y), bfhi(yw.y)};
                y = y * rsy * gn;
                if (G) { const u32x2 gw2 = *(const u32x2*)(G + (size_t)row * ldg + col); y = y * (f32x4){bflo(gw2.x), bfhi(gw2.x), bflo(gw2.y), bfhi(gw2.y)}; }
                h = h + y;
            }
            if (hout) *(f32x4*)(hout + (size_t)row * D + col) = h;
            u32x2 o; o.x = cvt_pk_bf16(h[0], h[1]); o.y = cvt_pk_bf16(h[2], h[3]); *(u32x2*)(hb + (size_t)row * D + col) = o;
            ss += (h[0] * h[0] + h[1] * h[1]) + (h[2] * h[2] + h[3] * h[3]);
        }
        ss = wave_sum(ss);
        if (lane == 0) rs[row] = 1.0f / sqrtf(ss * (1.0f / D) + NORM_EPS);
    }
}

__device__ __forceinline__ void attn_phase(LAS unsigned char* lds, bf16_t* P, bf16_t* Od, int ldo, int wid, int lane) {
    const int n = lane & 15, g = lane >> 4;
    LAS unsigned char* vb = lds + wid * 9216;
    const unsigned troff = (unsigned)((4 * g + ((lane & 15) >> 2)) * 144 + (lane & 3) * 8);
    for (int T = blockIdx.x * 8 + wid; T < 16384; T += gridDim.x * 8) {
        const int c = T & 15, blk = (T >> 4) & 15, bh = T >> 8, h = bh & 7, b = bh >> 3;
        const size_t rowbase = (size_t)b * SEQ;
        bf16_t* Pq = P + (rowbase + blk * 256 + c + 16 * n) * LDP + h * 64;
        const bf16x8 qf0 = *(const bf16x8*)(Pq + C_QA + 8 * g), qf1 = *(const bf16x8*)(Pq + C_QA + 32 + 8 * g);
        const bf16_t* Pb = P + rowbase * LDP + h * 64;
        bf16x8 kn[2][2]; u32x4 vn[4];
#define GRP(pi, sh, cr, kbase, iq0, iqs) int sh, cr, kbase, iq0, iqs; \
        if ((pi) < 5) { sh = 4; cr = c; kbase = blk * 16 - 64 + 32 * (pi); iq0 = blk * 16; iqs = 1; } \
        else if ((pi) < 11) { sh = 2; cr = c & 3; kbase = blk * 64 + (c >> 2) - 64 + 32 * ((pi) - 5); iq0 = blk * 64 + (c >> 2); iqs = 4; } \
        else { sh = 0; cr = 0; kbase = blk * 256 + c - 64 + 32 * ((pi) - 11); iq0 = blk * 256 + c; iqs = 16; }
#define LOADPAIR(pi) do { GRP(pi, sh_, cr_, kb_, iq0_, iqs_); (void)iq0_; (void)iqs_; const int L_ = SEQ >> sh_; \
        _Pragma("unroll") for (int t = 0; t < 2; ++t) { int ik = kb_ + 16 * t + n; ik = ik < 0 ? 0 : (ik >= L_ ? L_ - 1 : ik); const bf16_t* kp = Pb + (size_t)(cr_ + (ik << sh_)) * LDP + C_KA; \
            kn[t][0] = *(const bf16x8*)(kp + 8 * g); kn[t][1] = *(const bf16x8*)(kp + 32 + 8 * g); } \
        _Pragma("unroll") for (int x = 0; x < 4; ++x) { int ik = kb_ + (lane >> 3) + 8 * x; ik = ik < 0 ? 0 : (ik >= L_ ? L_ - 1 : ik); \
            vn[x] = *(const u32x4*)(Pb + (size_t)(cr_ + (ik << sh_)) * LDP + C_VA + (lane & 7) * 8); } } while (0)
        LOADPAIR(0);
        float mrun = -1e30f, lrun = 0.f; f32x4 ot[4];
#pragma unroll
        for (int t = 0; t < 4; ++t) ot[t] = (f32x4){0.f, 0.f, 0.f, 0.f};
        for (int pi = 0; pi < 23; ++pi) {
            bf16x8 kc[2][2]; u32x4 vc[4];
#pragma unroll
            for (int t = 0; t < 2; ++t) { kc[t][0] = kn[t][0]; kc[t][1] = kn[t][1]; }
#pragma unroll
            for (int x = 0; x < 4; ++x) vc[x] = vn[x];
            if (pi + 1 < 23) LOADPAIR(pi + 1);
            GRP(pi, sh, cr, kbase, iq0, iqs); (void)cr;
            const int L = SEQ >> sh, iqn = iq0 + iqs * n;
            LAS unsigned char* vbuf = vb + (pi & 1) * 4608;
#pragma unroll
            for (int x = 0; x < 4; ++x) *(LAS u32x4*)(vbuf + ((lane >> 3) + 8 * x) * 144 + (lane & 7) * 16) = vc[x];
            f32x4 s0 = (f32x4){0.f, 0.f, 0.f, 0.f}, s1 = (f32x4){0.f, 0.f, 0.f, 0.f};
            s0 = __builtin_amdgcn_mfma_f32_16x16x32_bf16(kc[0][0], qf0, s0, 0, 0, 0); s0 = __builtin_amdgcn_mfma_f32_16x16x32_bf16(kc[0][1], qf1, s0, 0, 0, 0);
            s1 = __builtin_amdgcn_mfma_f32_16x16x32_bf16(kc[1][0], qf0, s1, 0, 0, 0); s1 = __builtin_amdgcn_mfma_f32_16x16x32_bf16(kc[1][1], qf1, s1, 0, 0, 0);
            float tmax = -1e30f; bool ok0[4], ok1[4];
#pragma unroll
            for (int i = 0; i < 4; ++i) {
                const int ik0 = kbase + 4 * g + i, ik1 = ik0 + 16; const int d0 = iqn - ik0, d1 = iqn - ik1;
                ok0[i] = (ik0 >= 0) && (ik0 < L) && (d0 <= 64) && (d0 >= -64); ok1[i] = (ik1 >= 0) && (ik1 < L) && (d1 <= 64) && (d1 >= -64);
                if (ok0[i]) tmax = fmaxf(tmax, s0[i]); if (ok1[i]) tmax = fmaxf(tmax, s1[i]);
            }
            tmax = fmaxf(tmax, __shfl_xor(tmax, 16)); tmax = fmaxf(tmax, __shfl_xor(tmax, 32));
            const float mnew = fmaxf(mrun, tmax), alpha = __expf(mrun - mnew);
            f32x4 p0, p1; float ps = 0.f;
#pragma unroll
            for (int i = 0; i < 4; ++i) { p0[i] = ok0[i] ? __expf(s0[i] - mnew) : 0.f; p1[i] = ok1[i] ? __expf(s1[i] - mnew) : 0.f; ps += p0[i] + p1[i]; }
            lrun = lrun * alpha + ps; mrun = mnew;
#pragma unroll
            for (int t = 0; t < 4; ++t) ot[t] = ot[t] * alpha;
            const bf16x8 pf = pack8(p0, p1);
            asm volatile("" ::: "memory");
#pragma unroll
            for (int t = 0; t < 4; ++t) {
                const s16x4 lo = tr_read(vbuf + troff + t * 32), hi = tr_read(vbuf + troff + 16 * 144 + t * 32);
                ot[t] = __builtin_amdgcn_mfma_f32_16x16x32_bf16(cat8(lo, hi), pf, ot[t], 0, 0, 0);
            }
            asm volatile("" ::: "memory");
        }
#undef LOADPAIR
#undef GRP
        float l = lrun; l += __shfl_xor(l, 16); l += __shfl_xor(l, 32);
        const float inv = 1.0f / l;
#pragma unroll
        for (int t = 0; t < 4; ++t) { u32x2 o; o.x = cvt_pk_bf16(ot[t][0] * inv, ot[t][1] * inv); o.y = cvt_pk_bf16(ot[t][2] * inv, ot[t][3] * inv);
            *(u32x2*)(Od + (rowbase + blk * 256 + c + 16 * n) * ldo + h * 64 + 16 * t + 4 * g) = o; }
    }
}

__device__ __forceinline__ void ret_kv_phase(LAS unsigned char* lds, const bf16_t* P, bf16_t* KV, const float* dl, int tid, int wid, int lane) {
    constexpr int KF = 0, KB = 18432, VO = 36864;
    const int g = lane >> 4, li = lane & 15, trq = li >> 2, trp = li & 3;
    for (int unit = blockIdx.x; unit < 2048; unit += gridDim.x) {
        const int bh = unit >> 5, nn = unit & 31, b = bh >> 3, h = bh & 7;
        const float lgf = logsig(dl[h]), lgb = logsig(dl[8 + h]);
        const size_t row0 = (size_t)b * SEQ + nn * 128;
#pragma unroll
        for (int x = 0; x < 2; ++x) { const int q = tid + 512 * x, R = q >> 3, pc = q & 7;
            const u32x4 w = *(const u32x4*)(P + (row0 + R) * LDP + C_KR + h * 64 + pc * 8);
            const float zf = expf(lgf * (float)(127 - R)), zb = expf(lgb * (float)R);
            *(LAS u32x4*)(lds + KF + R * 144 + pc * 16) = scale8(w, zf); *(LAS u32x4*)(lds + KB + R * 144 + pc * 16) = scale8(w, zb); }
#pragma unroll
        for (int x = 0; x < 4; ++x) { const int q = tid + 512 * x, R = q >> 4, pc = q & 15;
            *(LAS u32x4*)(lds + VO + R * 272 + pc * 16) = *(const u32x4*)(P + (row0 + R) * LDP + C_VR + h * 128 + pc * 8); }
        __syncthreads();
        f32x4 acc[8];
#pragma unroll
        for (int i = 0; i < 8; ++i) acc[i] = (f32x4){0.f, 0.f, 0.f, 0.f};
#pragma unroll
        for (int ks = 0; ks < 4; ++ks) {
            const int tr0 = 32 * ks + 8 * g + trq;
            const bf16x8 af = cat8(tr_read(lds + VO + tr0 * 272 + (16 * wid + 4 * trp) * 2), tr_read(lds + VO + (tr0 + 4) * 272 + (16 * wid + 4 * trp) * 2));
#pragma unroll
            for (int dkt = 0; dkt < 8; ++dkt) {
                const int ko = (dkt < 4 ? KF : KB) + (16 * (dkt & 3) + 4 * trp) * 2;
                const bf16x8 bf = cat8(tr_read(lds + ko + tr0 * 144), tr_read(lds + ko + (tr0 + 4) * 144));
                acc[dkt] = __builtin_amdgcn_mfma_f32_16x16x32_bf16(af, bf, acc[dkt], 0, 0, 0);
            }
        }
        bf16_t* KVu = KV + (size_t)unit * 16384;
#pragma unroll
        for (int dkt = 0; dkt < 8; ++dkt) { u32x2 o; o.x = cvt_pk_bf16(acc[dkt][0], acc[dkt][1]); o.y = cvt_pk_bf16(acc[dkt][2], acc[dkt][3]);
            *(u32x2*)(KVu + (dkt >> 2) * 8192 + (16 * (dkt & 3) + li) * 128 + 16 * wid + 4 * g) = o; }
        __syncthreads();
    }
}
__device__ __forceinline__ void ret_scan_phase(bf16_t* KV, const float* dl, int tid) {
    const int gt = blockIdx.x * 512 + tid, NT = gridDim.x * 512;
    for (int e = gt; e < 64 * 8192; e += NT) {
        const int bh = e >> 13, pp = e & 8191, dir = pp >> 12, h = bh & 7;
        const float G = expf(128.0f * logsig(dl[dir * 8 + h]));
        unsigned* base = (unsigned*)KV + (size_t)bh * 32 * 8192 + pp;
        unsigned w[32];
#pragma unroll
        for (int st = 0; st < 32; ++st) w[st] = base[(size_t)st * 8192];
        float s0 = 0.f, s1 = 0.f;
        if (dir == 0) {
#pragma unroll
            for (int st = 0; st < 32; ++st) { const unsigned o = cvt_pk_bf16(s0, s1); s0 = s0 * G + bflo(w[st]); s1 = s1 * G + bfhi(w[st]); w[st] = o; }
        } else {
#pragma unroll
            for (int st = 31; st >= 0; --st) { const unsigned o = cvt_pk_bf16(s0, s1); s0 = s0 * G + bflo(w[st]); s1 = s1 * G + bfhi(w[st]); w[st] = o; }
        }
#pragma unroll
        for (int st = 0; st < 32; ++st) base[(size_t)st * 8192] = w[st];
    }
}
__device__ __forceinline__ void ret_out_phase(LAS unsigned char* lds, bf16_t* P, int ocol, const bf16_t* KV, const float* dl, int tid, int wid, int lane) {
    constexpr int KO = 0, VO = 18432, SF = 53248, SB = 70656;
    const int g = lane >> 4, li = lane & 15, trq = li >> 2, trp = li & 3;
    for (int unit = blockIdx.x; unit < 2048; unit += gridDim.x) {
        const int bh = unit >> 5, nn = unit & 31, b = bh >> 3, h = bh & 7;
        const float lgf = logsig(dl[h]), lgb = logsig(dl[8 + h]);
        const size_t row0 = (size_t)b * SEQ + nn * 128;
        const bf16_t* KVu = KV + (size_t)unit * 16384;
#pragma unroll
        for (int x = 0; x < 2; ++x) { const int q = tid + 512 * x, R = q >> 3, pc = q & 7;
            *(LAS u32x4*)(lds + KO + R * 144 + pc * 16) = *(const u32x4*)(P + (row0 + R) * LDP + C_KR + h * 64 + pc * 8); }
#pragma unroll
        for (int x = 0; x < 4; ++x) { const int q = tid + 512 * x, R = q >> 4, pc = q & 15;
            *(LAS u32x4*)(lds + VO + R * 272 + pc * 16) = *(const u32x4*)(P + (row0 + R) * LDP + C_VR + h * 128 + pc * 8); }
#pragma unroll
        for (int x = 0; x < 4; ++x) { const int q = tid + 512 * x, dir = q >> 10, R = (q >> 4) & 63, pc = q & 15;
            *(LAS u32x4*)(lds + (dir ? SB : SF) + R * 272 + pc * 16) = *(const u32x4*)(KVu + dir * 8192 + R * 128 + pc * 8); }
        const int a = 16 * wid + li;
        bf16_t* Pr = P + (row0 + a) * LDP;
        const u32x4 q0 = *(const u32x4*)(Pr + C_QR + h * 64 + 8 * g), q1 = *(const u32x4*)(Pr + C_QR + h * 64 + 32 + 8 * g);
        const float xf = expf(lgf * (float)(a + 1)), xb = expf(lgb * (float)(128 - a));
        const bf16x8 qr0 = __builtin_bit_cast(bf16x8, q0), qr1 = __builtin_bit_cast(bf16x8, q1);
        const bf16x8 qf0 = __builtin_bit_cast(bf16x8, scale8(q0, xf)), qf1 = __builtin_bit_cast(bf16x8, scale8(q1, xf));
        const bf16x8 qb0 = __builtin_bit_cast(bf16x8, scale8(q0, xb)), qb1 = __builtin_bit_cast(bf16x8, scale8(q1, xb));
        __syncthreads();
        bf16x8 pf[4];
#pragma unroll
        for (int kp = 0; kp < 4; ++kp) {
            f32x4 st[2];
#pragma unroll
            for (int t = 0; t < 2; ++t) {
                const int kt = 2 * kp + t;
                const bf16x8 k0 = *(const LAS bf16x8*)(lds + KO + (16 * kt + li) * 144 + 16 * g), k1 = *(const LAS bf16x8*)(lds + KO + (16 * kt + li) * 144 + 64 + 16 * g);
                f32x4 s = (f32x4){0.f, 0.f, 0.f, 0.f};
                s = __builtin_amdgcn_mfma_f32_16x16x32_bf16(k0, qr0, s, 0, 0, 0); s = __builtin_amdgcn_mfma_f32_16x16x32_bf16(k1, qr1, s, 0, 0, 0);
#pragma unroll
                for (int i = 0; i < 4; ++i) { const int key = 16 * kt + 4 * g + i, d = a - key; const float w = d >= 0 ? expf(lgf * (float)d) : expf(lgb * (float)(-d)); s[i] *= w; }
                st[t] = s;
            }
            pf[kp] = pack8(st[0], st[1]);
        }
        f32x4 acc[8];
#pragma unroll
        for (int dt = 0; dt < 8; ++dt) {
            f32x4 c = (f32x4){0.f, 0.f, 0.f, 0.f};
            const int co = (16 * dt + 4 * trp) * 2;
#pragma unroll
            for (int kp = 0; kp < 4; ++kp) {
                const bf16x8 vf = cat8(tr_read(lds + VO + (32 * kp + 4 * g + trq) * 272 + co), tr_read(lds + VO + (32 * kp + 16 + 4 * g + trq) * 272 + co));
                c = __builtin_amdgcn_mfma_f32_16x16x32_bf16(vf, pf[kp], c, 0, 0, 0);
            }
#pragma unroll
            for (int ks = 0; ks < 2; ++ks) {
                const int r0 = 32 * ks + 8 * g + trq;
                const bf16x8 sf = cat8(tr_read(lds + SF + r0 * 272 + co), tr_read(lds + SF + (r0 + 4) * 272 + co));
                c = __builtin_amdgcn_mfma_f32_16x16x32_bf16(sf, ks ? qf1 : qf0, c, 0, 0, 0);
                const bf16x8 sb = cat8(tr_read(lds + SB + r0 * 272 + co), tr_read(lds + SB + (r0 + 4) * 272 + co));
                c = __builtin_amdgcn_mfma_f32_16x16x32_bf16(sb, ks ? qb1 : qb0, c, 0, 0, 0);
            }
            acc[dt] = c;
        }
        float s = 0.f;
#pragma unroll
        for (int dt = 0; dt < 8; ++dt) s += (acc[dt][0] + acc[dt][1]) + (acc[dt][2] + acc[dt][3]);
        s += __shfl_xor(s, 16); s += __shfl_xor(s, 32);
        const float mu = s * (1.0f / 128.0f); float vq = 0.f;
#pragma unroll
        for (int dt = 0; dt < 8; ++dt) { const f32x4 d = acc[dt] - mu; vq += (d[0] * d[0] + d[1] * d[1]) + (d[2] * d[2] + d[3] * d[3]); }
        vq += __shfl_xor(vq, 16); vq += __shfl_xor(vq, 32);
        const float rstd = 1.0f / sqrtf(vq * (1.0f / 128.0f) + GN_EPS);
#pragma unroll
        for (int dt = 0; dt < 8; ++dt) {
            const int col = h * 128 + 16 * dt + 4 * g;
            const u32x2 gw = *(const u32x2*)(Pr + C_GR + col);
            const f32x4 y = (acc[dt] - mu) * rstd;
            u32x2 o; o.x = cvt_pk_bf16(y[0] * bflo(gw.x), y[1] * bfhi(gw.x)); o.y = cvt_pk_bf16(y[2] * bflo(gw.y), y[3] * bfhi(gw.y));
            *(u32x2*)(Pr + ocol + col) = o;
        }
        __syncthreads();
    }
}


#define XB_TMO      128
#define XB_XCNT(j)  (256  + 64 * (j))
#define XB_XSUB(j)  (1280 + 64 * (j))
#define XB_XGEN(j)  (2304 + 64 * (j))
#define XB_TOP      3328
#define XB_TOPGEN   3392
#define XCD_BAR_WORDS 3456
#define XB_SPIN_CAP (1u << 22)
__device__ __forceinline__ unsigned xb_ld(unsigned* p)              { return __hip_atomic_load(p, __ATOMIC_RELAXED, __HIP_MEMORY_SCOPE_AGENT); }
__device__ __forceinline__ unsigned xb_add(unsigned* p, unsigned v) { return __hip_atomic_fetch_add(p, v, __ATOMIC_RELAXED, __HIP_MEMORY_SCOPE_AGENT); }
__device__ __forceinline__ unsigned xb_xcc_id() { return (unsigned)__builtin_amdgcn_s_getreg((3 << 11) | 20) & 0xFu; }
#define XB_SPIN(cond, bar) do { unsigned _sp = 0; while (cond) { __builtin_amdgcn_s_sleep(1); \
    if ((++_sp & 255u) == 0u) { if (xb_ld(&(bar)[XB_TMO])) break; if (_sp > XB_SPIN_CAP) { atomicAdd(&(bar)[XB_TMO], 1u); break; } } } } while (0)
__device__ __forceinline__ void xcd_barrier_complete(unsigned* bar, unsigned x, unsigned& nloc, unsigned& nx) {
    const unsigned G = gridDim.x * gridDim.y * gridDim.z;
    unsigned sum, cnt, mine, sp = 0u;
    for (;;) {
        sum = 0u; cnt = 0u; mine = 0u;
#pragma unroll
        for (unsigned j = 0; j < 16; ++j) { const unsigned c = xb_ld(&bar[XB_XCNT(j)]); sum += c; cnt += (c > 0u) ? 1u : 0u; mine = (j == x) ? c : mine; }
        if (sum == G) break;
        __builtin_amdgcn_s_sleep(1);
        if ((++sp & 255u) == 0u) { if (xb_ld(&bar[XB_TMO])) break; if (sp > XB_SPIN_CAP) { atomicAdd(&bar[XB_TMO], 1u); break; } }
    }
    nloc = mine > 0u ? mine : 1u; nx = cnt > 0u ? cnt : 1u;
}
__device__ __forceinline__ void xcd_barrier(unsigned* bar, unsigned x, volatile LAS unsigned* st) {
    asm volatile("s_waitcnt vmcnt(0)" ::: "memory");
    __syncthreads();
    if (threadIdx.x == 0) {
        __builtin_amdgcn_s_waitcnt(0);
        unsigned nloc = st[0], nx = st[1];
        if (nloc == 0u) { xcd_barrier_complete(bar, x, nloc, nx); st[0] = nloc; st[1] = nx; }
        const unsigned old = xb_add(&bar[XB_XSUB(x)], 1u);
        const unsigned gen = old / nloc;
        if (old + 1u == (gen + 1u) * nloc) {
            __builtin_amdgcn_fence(__ATOMIC_RELEASE, "agent");
            asm volatile("s_waitcnt vmcnt(0)" ::: "memory");
            const unsigned og = xb_add(&bar[XB_TOP], 1u);
            const unsigned tg = og / nx;
            if (og + 1u == (tg + 1u) * nx) xb_add(&bar[XB_TOPGEN], 1u);
            else XB_SPIN(xb_ld(&bar[XB_TOPGEN]) == tg, bar);
            __builtin_amdgcn_fence(__ATOMIC_ACQUIRE, "agent");
            xb_add(&bar[XB_XGEN(x)], 1u);
            asm volatile("s_waitcnt vmcnt(0)" ::: "memory");
        } else {
            XB_SPIN(xb_ld(&bar[XB_XGEN(x)]) == gen, bar);
            __builtin_amdgcn_fence(__ATOMIC_ACQUIRE, "agent");
            asm volatile("s_waitcnt vmcnt(0)" ::: "memory");
        }
    }
    __syncthreads();
}

#ifndef DBG_STOP
#define DBG_STOP 0
#endif
__device__ __forceinline__ void dbg_dump(float* out, const bf16_t* s0, int ld0, int w0, const bf16_t* s1, int ld1, int w1) {
    const int gt = blockIdx.x * 512 + threadIdx.x, NT = gridDim.x * 512;
    for (int e = gt; e < M * D; e += NT) { const int row = e >> 10, c = e & 1023; float v = 0.f;
        for (int j = 0; c + 1024 * j < w0; ++j) v += bflo((unsigned)s0[(size_t)row * ld0 + c + 1024 * j]);
        if (s1) for (int j = 0; c + 1024 * j < w1; ++j) v += bflo((unsigned)s1[(size_t)row * ld1 + c + 1024 * j]);
        out[e] = v; }
}
#define DBG(k, s0, ld0, w0, s1, ld1, w1) do { if (DBG_STOP == (k) && layer == 0) { dbg_dump(hout, s0, ld0, w0, s1, ld1, w1); return; } } while (0)
#define DBGRET(k) do { if (DBG_STOP == (k) && layer == 0) return; } while (0)
#define GRID_SYNC() xcd_barrier((unsigned*)WSP(WS_CTL), xcc_id, (volatile LAS unsigned*)(lds + LDS_BYTES - 64))
__global__ void __launch_bounds__(512, 2) fwd_kernel(Args a) {
    extern __shared__ __attribute__((aligned(16))) unsigned char lds_raw[];
    LAS unsigned char* lds = (LAS unsigned char*)lds_raw;
    cg::grid_group grid = cg::this_grid();
    const unsigned xcc_id = xb_xcc_id();
    if (threadIdx.x < 16) ((LAS unsigned*)(lds + LDS_BYTES - 64))[threadIdx.x] = 0u;
    __syncthreads();
    if (threadIdx.x == 0) (void)xb_add((unsigned*)WSP(WS_CTL) + XB_XCNT(xcc_id), 1u);
    grid.sync();
    const int G = gridDim.x, cb = blockIdx.x;
#define WB ((bf16_t*)WSP(WS_WB))
#define tabA ((const f32x2*)WSP(WS_TABA))
#define tabR ((const f32x2*)WSP(WS_TABR))
#define rs ((float*)WSP(WS_RS))
#define part ((float*)WSP(WS_PART))
#define hb ((bf16_t*)WSP(WS_HB))
#define pb ((bf16_t*)WSP(WS_PB))
#define KV ((bf16_t*)WSP(WS_KV))
#define P ((bf16_t*)WSP(WS_PROJ))
#define hout (KA()->out)

#ifndef PHM
#define PHM 0xffff
#endif
#ifndef DUP
#define DUP 0
#endif
#define REP(bit) _Pragma("unroll 1") for (int rep_ = 0; rep_ < ((DUP & (bit)) ? 2 : 1); ++rep_)
    { const int tid = threadIdx.x, wid = __builtin_amdgcn_readfirstlane(tid >> 6), lane = tid & 63; (void)tid;
    if (PHM & 1) build_tables(KA());
    if (PHM & 2) convert_layer(KA(), 0, lds, wid, lane);
    if (PHM & 4) row_pass(KA()->in[0], nullptr, nullptr, 0, nullptr, nullptr, nullptr, 0, hb, rs, wid, lane); }
    GRID_SYNC();

#pragma unroll 1
    for (int layer = 0; layer < DEPTH; ++layer) {
        const float* dl = KA()->in[10] + layer * 16;
        if (DUP & 512) { _Pragma("unroll 1") for (int xs = 0; xs < 20; ++xs) GRID_SYNC(); }
        int tid = threadIdx.x; asm volatile("" : "+v"(tid));
        const int wid = __builtin_amdgcn_readfirstlane(tid >> 6), lane = tid & 63;
        REP(1) if (PHM & 8) { pg8::Gemm g{hb, WB + WB_IN, M, 4608, 1024, 1024, 1024}; pg8::StaticOrder S; S.init(M, 4608, G, cb);
          pg8::EpiProj E{P, rs, tabA, tabR}; pg8::gemm_phase<pg8::EpiProj>(lds, g, S, E); }
        GRID_SYNC();
        DBG(1, P, LDP, 4608, nullptr, 0, 0);
        if (DUP & 128) { attn_phase(lds, P, KV, 512, wid, lane); GRID_SYNC(); }
        if (PHM & 16) attn_phase(lds, P, P, LDP, wid, lane);
        __syncthreads();
        REP(64) if (PHM & 32) ret_kv_phase(lds, P, KV, dl, tid, wid, lane);
        GRID_SYNC();
        DBG(2, P, LDP, 512, KV, 1024, 1024);
        if (PHM & 64) ret_scan_phase(KV, dl, tid);
        GRID_SYNC();
        DBG(3, KV, 1024, 1024, nullptr, 0, 0);
        REP(256) if (PHM & 128) ret_out_phase(lds, P, ((DUP & 256) && rep_ == 0) ? C_S1 : C_VR, KV, dl, tid, wid, lane);
        GRID_SYNC();
        DBG(4, P + C_VR, LDP, 1024, nullptr, 0, 0);
        if (PHM & 256) { pg8::StaticOrder S; S.init(M, 1024, G, cb);
          REP(2) { pg8::Gemm g{hb, WB + WB_GA, M, 1024, 1024, 1024, 1024}; pg8::EpiAct<0> E{P + C_S1, LDP, rs}; pg8::gemm_phase<pg8::EpiAct<0>>(lds, g, S, E); }
          { pg8::Gemm g{P + C_QA, WB + WB_AO, M, 1024, 512, LDP, 512}; pg8::EpiMulAdd E{P + C_S1, nullptr, LDP}; pg8::gemm_phase<pg8::EpiMulAdd>(lds, g, S, E); }
          REP(2) { pg8::Gemm g{hb, WB + WB_GB, M, 1024, 1024, 1024, 1024}; pg8::EpiAct<0> E{P + C_S2, LDP, rs}; pg8::gemm_phase<pg8::EpiAct<0>>(lds, g, S, E); }
          { pg8::Gemm g{P + C_VR, WB + WB_RO, M, 1024, 1024, LDP, 1024}; pg8::EpiMulAdd E{P + C_S2, P + C_S1, LDP}; pg8::gemm_phase<pg8::EpiMulAdd>(lds, g, S, E); } }
        GRID_SYNC();
        DBG(5, P + C_S2, LDP, 1024, nullptr, 0, 0);
        REP(4) if (PHM & 512) { pg8::Gemm g{P + C_S2, WB + WB_WO, M, 1024, 1024, LDP, 1024}; pg8::StaticOrder S; S.init(M, 1024, G, cb);
          pg8::EpiY E{P + C_Y, LDP, part}; pg8::gemm_phase<pg8::EpiY>(lds, g, S, E); }
        GRID_SYNC();
        DBG(6, P + C_Y, LDP, 1024, nullptr, 0, 0);
        if (DUP & 1024) row_pass(layer == 0 ? KA()->in[0] : hout, nullptr, P + C_Y, LDP, part, KA()->in[12] + layer * D, nullptr, 0, KV, (float*)WSP(WS_CTL + 65536), wid, lane);
        row_pass(layer == 0 ? KA()->in[0] : hout, hout, P + C_Y, LDP, part, KA()->in[12] + layer * D, nullptr, 0, hb, rs, wid, lane);
        GRID_SYNC();
        DBGRET(7);
        REP(8) if (PHM & 1024) { pg8::Gemm g{hb, WB + WB_UP, M, FF, 1024, 1024, 1024}; pg8::StaticOrder S; S.init(M, FF, G, cb);
          pg8::EpiAct<1> E{P, FF, rs}; pg8::gemm_phase<pg8::EpiAct<1>>(lds, g, S, E); }
        GRID_SYNC();
        DBG(8, P, FF, 4096, nullptr, 0, 0);
        REP(16) if (PHM & 2048) { pg8::Gemm g{P, WB + WB_DN, M, 1024, FF, FF, FF}; pg8::StaticOrder S; S.init(M, 1024, G, cb);
          pg8::EpiY E{KV, 1024, part}; pg8::gemm_phase<pg8::EpiY>(lds, g, S, E); }
        GRID_SYNC();
        DBG(9, KV, 1024, 1024, nullptr, 0, 0);
        if (DUP & 1024) row_pass(hout, nullptr, KV, 1024, part, KA()->in[14] + layer * D, nullptr, 0, P, (float*)WSP(WS_CTL + 65536), wid, lane);
        row_pass(hout, hout, KV, 1024, part, KA()->in[14] + layer * D, nullptr, 0, hb, rs, wid, lane);
        GRID_SYNC();
        DBGRET(10);
        if (PHM & 4096) { pg8::StaticOrder S; S.init(M, 1024, G, cb);
          REP(32) { pg8::Gemm g{hb, WB + WB_PG, M, 1024, 1024, 1024, 1024}; pg8::EpiAct<0> E{P, 1024, rs}; pg8::gemm_phase<pg8::EpiAct<0>>(lds, g, S, E); }
          REP(32) { pg8::Gemm g{pb, WB + WB_PP, M, 1024, PLE, PLE, PLE}; pg8::EpiY E{KV, 1024, part}; pg8::gemm_phase<pg8::EpiY>(lds, g, S, E); } }
        GRID_SYNC();
        DBG(11, P, 1024, 1024, KV, 1024, 1024);
        if (DUP & 1024) row_pass(hout, nullptr, KV, 1024, part, KA()->in[15] + layer * D, P, 1024, P + (size_t)M * 1024, (float*)WSP(WS_CTL + 65536), wid, lane);
        row_pass(hout, hout, KV, 1024, part, KA()->in[15] + layer * D, P, 1024, hb, rs, wid, lane);
        if (layer + 1 < DEPTH) convert_layer(KA(), layer + 1, lds, wid, lane);
        GRID_SYNC();
        DBGRET(12);
    }
}
#undef WB
#undef tabA
#undef tabR
#undef rs
#undef part
#undef hb
#undef pb
#undef KV
#undef P
#undef hout

extern "C" void kernel_launch(void* const* d_in, const int* in_sizes, int n_in, void* d_out, int out_size, void* d_ws, size_t ws_size, hipStream_t stream) {
    static int grid = 0;
    if (grid == 0) {
        if (n_in != 16 || out_size != M * D || ws_size < WS_END) { fprintf(stderr, "kernel_launch: unexpected shapes/workspace (n_in %d out %d ws %zu)\n", n_in, out_size, ws_size); grid = -1; return; }
        int dev = 0, cus = 0, per_cu = 0;
        hipGetDevice(&dev); hipDeviceGetAttribute(&cus, hipDeviceAttributeMultiprocessorCount, dev);
        hipFuncSetAttribute((const void*)fwd_kernel, hipFuncAttributeMaxDynamicSharedMemorySize, LDS_BYTES);
        hipOccupancyMaxActiveBlocksPerMultiprocessor(&per_cu, (const void*)fwd_kernel, 512, LDS_BYTES);
        if (per_cu < 1) per_cu = 1;
        grid = cus * 1;
        (void)hipGetLastError();
    }
    if (grid < 0) return;
    if (hipMemsetAsync((char*)d_ws + WS_CTL, 0, XCD_BAR_WORDS * 4, stream) != hipSuccess) { fprintf(stderr, "memset failed\n"); return; }
    Args a{};
    for (int i = 0; i < 16; ++i) a.in[i] = (const float*)d_in[i];
    a.out = (float*)d_out; a.ws = (unsigned char*)d_ws;
    void* args[] = {&a};
    hipError_t e = hipLaunchCooperativeKernel((const void*)fwd_kernel, dim3(grid), dim3(512), args, LDS_BYTES, stream);
    if (e != hipSuccess) fprintf(stderr, "cooperative launch failed: %s (grid %d)\n", hipGetErrorString(e), grid);
}
```

```cpp
#include <hip/hip_runtime.h>
#include <hip/hip_cooperative_groups.h>
#include <cstdio>
#include <cstdint>
namespace cg = cooperative_groups;

#define LAS __attribute__((address_space(3)))
typedef unsigned short bf16_t;
typedef short bf16x8 __attribute__((ext_vector_type(8)));
typedef short s16x4 __attribute__((ext_vector_type(4)));
typedef short v4i16_t __attribute__((ext_vector_type(4)));
typedef float f32x4 __attribute__((ext_vector_type(4)));
typedef float f32x2 __attribute__((ext_vector_type(2)));
typedef unsigned u32x4 __attribute__((ext_vector_type(4)));
typedef unsigned u32x2 __attribute__((ext_vector_type(2)));

constexpr int M = 32768, D = 1024, SEQ = 4096, DEPTH = 4, FF = 4096, PLE = 256;
constexpr int LDP = 4608;
constexpr int C_QA = 0, C_KA = 512, C_VA = 1024, C_QR = 1536, C_KR = 2048, C_VR = 2560, C_GR = 3584;
constexpr int C_S1 = 512, C_S2 = 1536, C_Y = 3584;
constexpr float NORM_EPS = 1e-6f, GN_EPS = 1e-5f;
constexpr size_t MiB = 1u << 20;
constexpr size_t WS_WB = 0;
constexpr size_t WB_IN = 0, WB_GA = (size_t)4608 * 1024, WB_GB = (size_t)5632 * 1024, WB_AO = (size_t)6656 * 1024, WB_RO = WB_AO + 1024 * 512,
                 WB_WO = WB_RO + 1024 * 1024, WB_UP = WB_WO + 1024 * 1024, WB_DN = WB_UP + 4096 * 1024, WB_PG = WB_DN + 4096 * 1024, WB_PP = WB_PG + 1024 * 1024;
constexpr size_t WS_TABA = 37 * MiB, WS_TABR = WS_TABA + 4096 * 8 * 8;
constexpr size_t WS_CTL = 38 * MiB + 512 * 1024;
constexpr size_t WS_RS = 39 * MiB, WS_PART = 40 * MiB;
constexpr size_t WS_HB = 42 * MiB, WS_PB = 106 * MiB, WS_KV = 122 * MiB, WS_PROJ = 186 * MiB, WS_END = 474 * MiB;
constexpr int LDS_BYTES = 147456;

typedef __bf16 bf16x2_t __attribute__((ext_vector_type(2)));
__device__ __forceinline__ unsigned cvt_pk_bf16(float lo, float hi) { const f32x2 v = {lo, hi}; const bf16x2_t b = __builtin_convertvector(v, bf16x2_t); return __builtin_bit_cast(unsigned, b); }
__device__ __forceinline__ float bflo(unsigned w) { return __uint_as_float(w << 16); }
__device__ __forceinline__ float bfhi(unsigned w) { return __uint_as_float(w & 0xffff0000u); }
__device__ __forceinline__ float sigmoidf_(float x) { return __builtin_amdgcn_rcpf(1.0f + __expf(-x)); }
__device__ __forceinline__ float wave_sum(float v) {
#pragma unroll
    for (int o = 1; o < 64; o <<= 1) v += __shfl_xor(v, o);
    return v;
}
__device__ __forceinline__ float logsig(float x) { return -log1pf(expf(-x)); }
__device__ __forceinline__ s16x4 tr_read(LAS unsigned char* p) { return __builtin_bit_cast(s16x4, __builtin_amdgcn_ds_read_tr16_b64_v4i16((LAS v4i16_t*)p)); }
__device__ __forceinline__ bf16x8 cat8(s16x4 lo, s16x4 hi) { return (bf16x8){lo[0], lo[1], lo[2], lo[3], hi[0], hi[1], hi[2], hi[3]}; }
__device__ __forceinline__ bf16x8 pack8(f32x4 a, f32x4 b) { u32x4 w; w.x = cvt_pk_bf16(a[0], a[1]); w.y = cvt_pk_bf16(a[2], a[3]); w.z = cvt_pk_bf16(b[0], b[1]); w.w = cvt_pk_bf16(b[2], b[3]); return __builtin_bit_cast(bf16x8, w); }
__device__ __forceinline__ u32x4 scale8(u32x4 w, float s) {
    u32x4 o; o.x = cvt_pk_bf16(bflo(w.x) * s, bfhi(w.x) * s); o.y = cvt_pk_bf16(bflo(w.y) * s, bfhi(w.y) * s);
    o.z = cvt_pk_bf16(bflo(w.z) * s, bfhi(w.z) * s); o.w = cvt_pk_bf16(bflo(w.w) * s, bfhi(w.w) * s); return o;
}

namespace pg8 {
constexpr int BM = 256, BK = 64, HALF = 128, HTB = HALF * BK * 2, STAGE_BYTES = 8 * HTB, NXCD = 8, WGM = 8;
__host__ __device__ __forceinline__ int lds_byte(int r, int c) { const int st = (r >> 4) * 2 + (c >> 5), rr = r & 15, cc = c & 31, ob = rr * 64 + cc * 2; return st * 1024 + (ob ^ (((ob >> 9) & 1) << 5)); }
__host__ __device__ __forceinline__ void stage_rc(int b, int& R, int& C) { const int st = b / 1024, sb = b % 1024, swz = sb ^ (((sb >> 9) & 1) << 5); R = (st >> 1) * 16 + swz / 64; C = (st & 1) * 32 + (swz % 64) / 2; }
__host__ __device__ __forceinline__ int perm32(int rho) { const int n = rho >> 4, i = rho & 15; return 8 * (i >> 2) + 4 * n + (i & 3); }
struct Unit { int pm, pn; };
struct Gemm { const bf16_t* A; const bf16_t* Bt; int M, N, K, lda, ldb; };
struct StaticOrder {
    int nM, nN, nwg, G, c;
    __device__ void init(int M_, int N_, int G_, int c_) { nM = M_ / BM; nN = N_ / BM; nwg = nM * nN; G = G_; c = c_; }
    __device__ bool next(int i, Unit& u) const {
        const long L = (long)i * G + c; if (L >= nwg) return false;
        int wgid = (int)L; { const int q = nwg / NXCD, r = nwg % NXCD, xcd = wgid % NXCD, off = wgid / NXCD; wgid = (xcd < r ? xcd * (q + 1) : r * (q + 1) + (xcd - r) * q) + off; }
        const int nig = WGM * nN, gid = wgid / nig, fm = gid * WGM, gsz = (nM - fm) < WGM ? (nM - fm) : WGM;
        u.pm = fm + ((wgid % nig) % gsz); u.pn = (wgid % nig) / gsz; return true;
    }
};
#define EPI_ARGS const f32x4 (&acc)[2][2][4][2], const Unit& u, int wr, int wc, int fr, int fq

struct EpiProj {
    static constexpr bool PERM = true;
    bf16_t* O; const float* rs; const f32x2* tabA; const f32x2* tabR;
    __device__ __forceinline__ void operator()(EPI_ARGS) const {
        const int pn = u.pn; int kind = 0; float sc = 1.f;
        if (pn < 2) { kind = 1; sc = 0.125f; } else if (pn < 4) kind = 1; else if (pn < 6) kind = 0; else if (pn < 8) kind = 2; else if (pn < 10) { kind = 2; sc = 0.125f; } else if (pn < 14) kind = 0; else kind = 3;
        const int row0 = u.pm * BM + wr * 64 + fr, colb = pn * BM + wc * 32 + 8 * fq;
#pragma unroll
        for (int ai = 0; ai < 2; ++ai)
#pragma unroll
            for (int m = 0; m < 4; ++m) {
                const int row = row0 + ai * HALF + m * 16; const float r = rs[row] * sc; const int pos = row & (SEQ - 1);
#pragma unroll
                for (int bj = 0; bj < 2; ++bj) {
                    const int c0 = colb + bj * HALF; f32x4 v0 = acc[ai][bj][m][0] * r, v1 = acc[ai][bj][m][1] * r;
                    if (kind == 1 || kind == 2) {
                        const int cm = c0 & 63;
                        if (kind == 2 || cm < 16) {
                            const f32x4* t = (kind == 1) ? (const f32x4*)(tabA + pos * 8 + (cm >> 1)) : (const f32x4*)(tabR + pos * 32 + (cm >> 1));
                            const f32x4 t0 = t[0], t1 = t[1];
                            f32x4 w0, w1;
                            w0[0] = v0[0] * t0[0] - v0[1] * t0[1]; w0[1] = v0[1] * t0[0] + v0[0] * t0[1]; w0[2] = v0[2] * t0[2] - v0[3] * t0[3]; w0[3] = v0[3] * t0[2] + v0[2] * t0[3];
                            w1[0] = v1[0] * t1[0] - v1[1] * t1[1]; w1[1] = v1[1] * t1[0] + v1[0] * t1[1]; w1[2] = v1[2] * t1[2] - v1[3] * t1[3]; w1[3] = v1[3] * t1[2] + v1[2] * t1[3];
                            v0 = w0; v1 = w1;
                        }
                    } else if (kind == 3) {
#pragma unroll
                        for (int j = 0; j < 4; ++j) { v0[j] = v0[j] * sigmoidf_(v0[j]); v1[j] = v1[j] * sigmoidf_(v1[j]); }
                    }
                    u32x4 w; w.x = cvt_pk_bf16(v0[0], v0[1]); w.y = cvt_pk_bf16(v0[2], v0[3]); w.z = cvt_pk_bf16(v1[0], v1[1]); w.w = cvt_pk_bf16(v1[2], v1[3]);
                    *(u32x4*)(O + (size_t)row * LDP + c0) = w;
                }
            }
    }
};
template <int ACT> struct EpiAct {
    static constexpr bool PERM = true;
    bf16_t* O; int ldc; const float* rs;
    __device__ __forceinline__ void operator()(EPI_ARGS) const {
        const int row0 = u.pm * BM + wr * 64 + fr, colb = u.pn * BM + wc * 32 + 8 * fq;
#pragma unroll
        for (int ai = 0; ai < 2; ++ai)
#pragma unroll
            for (int m = 0; m < 4; ++m) {
                const int row = row0 + ai * HALF + m * 16; const float r = rs[row];
#pragma unroll
                for (int bj = 0; bj < 2; ++bj) {
                    f32x4 v0 = acc[ai][bj][m][0] * r, v1 = acc[ai][bj][m][1] * r;
#pragma unroll
                    for (int j = 0; j < 4; ++j) {
                        if (ACT == 0) { v0[j] = sigmoidf_(v0[j]); v1[j] = sigmoidf_(v1[j]); }
                        else { const float a0 = fmaxf(v0[j], 0.f), a1 = fmaxf(v1[j], 0.f); v0[j] = a0 * a0; v1[j] = a1 * a1; }
                    }
                    u32x4 w; w.x = cvt_pk_bf16(v0[0], v0[1]); w.y = cvt_pk_bf16(v0[2], v0[3]); w.z = cvt_pk_bf16(v1[0], v1[1]); w.w = cvt_pk_bf16(v1[2], v1[3]);
                    *(u32x4*)(O + (size_t)row * ldc + colb + bj * HALF) = w;
                }
            }
    }
};
struct EpiMulAdd {
    static constexpr bool PERM = true;
    bf16_t* S; const bf16_t* T; int ld;
    __device__ __forceinline__ void operator()(EPI_ARGS) const {
        const int row0 = u.pm * BM + wr * 64 + fr, colb = u.pn * BM + wc * 32 + 8 * fq;
#pragma unroll
        for (int ai = 0; ai < 2; ++ai)
#pragma unroll
            for (int m = 0; m < 4; ++m) {
                const int row = row0 + ai * HALF + m * 16;
#pragma unroll
                for (int bj = 0; bj < 2; ++bj) {
                    const size_t off = (size_t)row * ld + colb + bj * HALF;
                    const u32x4 s = *(const u32x4*)(S + off); u32x4 t = (u32x4){0u, 0u, 0u, 0u}; if (T) t = *(const u32x4*)(T + off);
                    const f32x4 a0 = acc[ai][bj][m][0], a1 = acc[ai][bj][m][1];
                    u32x4 w;
                    w.x = cvt_pk_bf16(bflo(t.x) + bflo(s.x) * a0[0], bfhi(t.x) + bfhi(s.x) * a0[1]); w.y = cvt_pk_bf16(bflo(t.y) + bflo(s.y) * a0[2], bfhi(t.y) + bfhi(s.y) * a0[3]);
                    w.z = cvt_pk_bf16(bflo(t.z) + bflo(s.z) * a1[0], bfhi(t.z) + bfhi(s.z) * a1[1]); w.w = cvt_pk_bf16(bflo(t.w) + bflo(s.w) * a1[2], bfhi(t.w) + bfhi(s.w) * a1[3]);
                    *(u32x4*)(S + off) = w;
                }
            }
    }
};
struct EpiY {
    static constexpr bool PERM = true;
    bf16_t* Y; int ldc; float* part;
    __device__ __forceinline__ void operator()(EPI_ARGS) const {
        const int row0 = u.pm * BM + wr * 64 + fr, colb = u.pn * BM + wc * 32 + 8 * fq;
#pragma unroll
        for (int ai = 0; ai < 2; ++ai)
#pragma unroll
            for (int m = 0; m < 4; ++m) {
                const int row = row0 + ai * HALF + m * 16; float s = 0.f;
#pragma unroll
                for (int bj = 0; bj < 2; ++bj) {
                    const f32x4 v0 = acc[ai][bj][m][0], v1 = acc[ai][bj][m][1];
                    s += (v0[0] * v0[0] + v0[1] * v0[1]) + (v0[2] * v0[2] + v0[3] * v0[3]) + (v1[0] * v1[0] + v1[1] * v1[1]) + (v1[2] * v1[2] + v1[3] * v1[3]);
                    u32x4 w; w.x = cvt_pk_bf16(v0[0], v0[1]); w.y = cvt_pk_bf16(v0[2], v0[3]); w.z = cvt_pk_bf16(v1[0], v1[1]); w.w = cvt_pk_bf16(v1[2], v1[3]);
                    *(u32x4*)(Y + (size_t)row * ldc + colb + bj * HALF) = w;
                }
                s += __shfl_xor(s, 16); s += __shfl_xor(s, 32);
                if (fq == 0) part[(size_t)row * 16 + u.pn * 4 + wc] = s;
            }
    }
};

template <class Epi, bool ALIGN_EPI = true>
__device__ __forceinline__ void gemm_phase(LAS unsigned char* lds, const Gemm g, const StaticOrder& S, const Epi& E) {
    int tid_ = threadIdx.x; asm volatile("" : "+v"(tid_));
    const int tid = tid_, wid = __builtin_amdgcn_readfirstlane(tid >> 6), lane = tid & 63, wr = wid >> 2, wc = wid & 3, fr = lane & 15, fq = lane >> 4;
    const int K = g.K, nt = K / BK;
    unsigned voffA[2], voffB[2];
#pragma unroll
    for (int i = 0; i < 2; ++i) { int R, C; stage_rc(tid * 16 + i * 8192, R, C); const int Rb = Epi::PERM ? ((R & ~31) + perm32(R & 31)) : R;
        voffA[i] = (unsigned)(R * g.lda + C) * 2u; voffB[i] = (unsigned)(Rb * g.ldb + C) * 2u; }
    const size_t kstep = (size_t)(BK * 2);
    const size_t hstepA = (size_t)HALF * g.lda * 2, hstepB = (size_t)HALF * g.ldb * 2;
    const size_t tstepA = 2 * hstepA, tstepB = 2 * hstepB;
    const unsigned ldsw = (unsigned)wid * 1024u;
    const int aoff = lds_byte(wr * 64 + fr, fq * 8), boff = lds_byte(wc * 32 + fr, fq * 8);
#define PG8_SA(b, h) (((b) * 2 + (h)) * HTB)
#define PG8_SB(b, h) ((4 + (b) * 2 + (h)) * HTB)
#define PG8_STAGE(bufoff, gbase, voff) do { _Pragma("unroll") for (int _i = 0; _i < 2; ++_i) \
        __builtin_amdgcn_global_load_lds((const unsigned*)((const char*)(gbase) + (voff)[_i]), (LAS unsigned*)(lds + (bufoff) + ldsw + _i * 8192), 16, 0, 0); } while (0)
#define PG8_LDA(dst, b, h) do { _Pragma("unroll") for (int m = 0; m < 4; ++m) _Pragma("unroll") for (int k = 0; k < 2; ++k) dst[m][k] = *(const LAS bf16x8*)(lds + PG8_SA(b, h) + aoff + m * 2048 + k * 1024); } while (0)
#define PG8_LDB(dst, b, h) do { _Pragma("unroll") for (int n = 0; n < 2; ++n) _Pragma("unroll") for (int k = 0; k < 2; ++k) dst[n][k] = *(const LAS bf16x8*)(lds + PG8_SB(b, h) + boff + n * 2048 + k * 1024); } while (0)
#define PG8_MMA(ai, bj, At, Bt) do { __builtin_amdgcn_s_setprio(1); _Pragma("unroll") for (int m = 0; m < 4; ++m) _Pragma("unroll") for (int n = 0; n < 2; ++n) _Pragma("unroll") for (int k = 0; k < 2; ++k) \
        acc[ai][bj][m][n] = __builtin_amdgcn_mfma_f32_16x16x32_bf16(Bt[n][k], At[m][k], acc[ai][bj][m][n], 0, 0, 0); __builtin_amdgcn_s_setprio(0); } while (0)
#define PG8_WAIT_V(n) asm volatile("s_waitcnt vmcnt(" #n ")" ::: "memory")
#define PG8_WAIT_L(n) asm volatile("s_waitcnt lgkmcnt(" #n ")" ::: "memory")
#define PG8_BAR __builtin_amdgcn_s_barrier()
#define PG8_SCHED __builtin_amdgcn_sched_barrier(0)
    Unit cur, nxt; int ui = 0;
    if (!S.next(0, cur)) return;
    f32x4 acc[2][2][4][2];
#pragma unroll
    for (int a = 0; a < 2; ++a)
#pragma unroll
        for (int b = 0; b < 2; ++b)
#pragma unroll
            for (int m = 0; m < 4; ++m)
#pragma unroll
                for (int n = 0; n < 2; ++n) acc[a][b][m][n] = (f32x4){0.f, 0.f, 0.f, 0.f};
    bf16x8 At[4][2], B0[2][2], B1[2][2];
    const char* cA = (const char*)g.A + (size_t)cur.pm * tstepA; const char* cB = (const char*)g.Bt + (size_t)cur.pn * tstepB;
    PG8_STAGE(PG8_SB(0, 0), cB, voffB); PG8_STAGE(PG8_SB(0, 1), cB + hstepB, voffB); PG8_STAGE(PG8_SA(0, 0), cA, voffA); PG8_STAGE(PG8_SA(0, 1), cA + hstepA, voffA);
    if (wr == 1) PG8_BAR;
    PG8_WAIT_V(2); PG8_BAR;
    PG8_STAGE(PG8_SB(1, 0), cB + kstep, voffB); PG8_STAGE(PG8_SA(1, 0), cA + kstep, voffA); PG8_STAGE(PG8_SB(1, 1), cB + hstepB + kstep, voffB);
    PG8_WAIT_V(6); PG8_BAR;
    for (;;) {
        const bool has_next = S.next(ui + 1, nxt);
        const char* nA = has_next ? (const char*)g.A + (size_t)nxt.pm * tstepA : cA; const char* nB = has_next ? (const char*)g.Bt + (size_t)nxt.pn * tstepB : cB;
#pragma unroll 1
        for (int t = 0; t < nt; t += 2) {
            const bool last = (t == nt - 2);
            const char* a1 = cA + (size_t)(t + 1) * kstep;
            const char* a2 = last ? nA : cA + (size_t)(t + 2) * kstep; const char* b2 = last ? nB : cB + (size_t)(t + 2) * kstep;
            const char* a3 = a2 + kstep; const char* b3 = b2 + kstep;
            PG8_LDB(B0, 0, 0); PG8_LDB(B1, 0, 1); PG8_SCHED; PG8_LDA(At, 0, 0); PG8_STAGE(PG8_SA(1, 1), a1 + hstepA, voffA);
            PG8_WAIT_V(8); PG8_WAIT_L(0); PG8_BAR; PG8_MMA(0, 0, At, B0); PG8_MMA(0, 1, At, B1); PG8_BAR; PG8_SCHED;
            PG8_LDA(At, 0, 1); PG8_STAGE(PG8_SB(0, 0), b2, voffB); PG8_STAGE(PG8_SB(0, 1), b2 + hstepB, voffB); PG8_STAGE(PG8_SA(0, 0), a2, voffA);
            PG8_WAIT_V(8); PG8_WAIT_L(0); PG8_BAR; PG8_MMA(1, 0, At, B0); PG8_MMA(1, 1, At, B1); PG8_BAR; PG8_SCHED;
            PG8_LDB(B0, 1, 0); PG8_LDB(B1, 1, 1); PG8_SCHED; PG8_LDA(At, 1, 0); PG8_STAGE(PG8_SA(0, 1), a2 + hstepA, voffA);
            PG8_WAIT_V(8); PG8_WAIT_L(0); PG8_BAR; PG8_MMA(0, 0, At, B0); PG8_MMA(0, 1, At, B1); PG8_BAR; PG8_SCHED;
            PG8_LDA(At, 1, 1); PG8_STAGE(PG8_SB(1, 0), b3, voffB); PG8_STAGE(PG8_SB(1, 1), b3 + hstepB, voffB); PG8_STAGE(PG8_SA(1, 0), a3, voffA);
            PG8_WAIT_V(8); PG8_WAIT_L(0); PG8_BAR; PG8_MMA(1, 0, At, B0); PG8_MMA(1, 1, At, B1); PG8_BAR; PG8_SCHED;
        }
        if constexpr (ALIGN_EPI) { if (wr == 0) PG8_BAR; }
        E(acc, cur, wr, wc, fr, fq);
        if (!has_next) break;
#pragma unroll
        for (int a = 0; a < 2; ++a)
#pragma unroll
            for (int b = 0; b < 2; ++b)
#pragma unroll
                for (int m = 0; m < 4; ++m)
#pragma unroll
                    for (int n = 0; n < 2; ++n) acc[a][b][m][n] = (f32x4){0.f, 0.f, 0.f, 0.f};
        cur = nxt; cA = nA; cB = nB; ++ui;
        if constexpr (ALIGN_EPI) { if (wr == 1) PG8_BAR; }
    }
    PG8_WAIT_V(0);
    if constexpr (!ALIGN_EPI) { if (wr == 0) PG8_BAR; }
    PG8_BAR;
#undef PG8_SA
#undef PG8_SB
#undef PG8_STAGE
#undef PG8_LDA
#undef PG8_LDB
#undef PG8_MMA
#undef PG8_WAIT_V
#undef PG8_WAIT_L
#undef PG8_BAR
#undef PG8_SCHED
}
}

__device__ __forceinline__ int win_src_col(int n) {
    if (n < 1024) { const int m = n & 63; if (m < 16) { const int i = m >> 1; return (n & ~63) + ((m & 1) ? i + 8 : i); } return n; }
    if (n >= 1536 && n < 2560) { const int m = n & 63, i = m >> 1; return (n & ~63) + ((m & 1) ? i + 32 : i); }
    return n;
}
template <bool MAP> __device__ __forceinline__ void transpose_item(const float* W, int K, int N, const float* gain, bf16_t* WT, LAS float* scr, int item, int lane) {
    const int nblk = N / 32, kb = item / nblk, nb = item % nblk, k0 = 64 * kb, n0 = 32 * nb;
    const int nd = n0 + (lane & 31); const int ns = MAP ? win_src_col(nd) : nd;
#pragma unroll 8
    for (int i = 0; i < 32; ++i) { const int kk = 2 * i + (lane >> 5); float v = W[(size_t)(k0 + kk) * N + ns]; if (gain) v *= gain[k0 + kk]; scr[kk * 33 + (lane & 31)] = v; }
    asm volatile("s_waitcnt lgkmcnt(0)" ::: "memory");
    const int c = lane & 7;
#pragma unroll
    for (int j = 0; j < 4; ++j) { const int n = (lane >> 3) + 8 * j; const LAS float* s = scr + (8 * c) * 33 + n;
        u32x4 o; o.x = cvt_pk_bf16(s[0 * 33], s[1 * 33]); o.y = cvt_pk_bf16(s[2 * 33], s[3 * 33]); o.z = cvt_pk_bf16(s[4 * 33], s[5 * 33]); o.w = cvt_pk_bf16(s[6 * 33], s[7 * 33]);
        *(u32x4*)(WT + (size_t)(n0 + n) * K + k0 + 8 * c) = o; }
    asm volatile("s_waitcnt lgkmcnt(0)" ::: "memory");
}

struct Args { const float* in[16]; float* out; unsigned char* ws; };
typedef const __attribute__((address_space(4))) Args* KArgs;
#define KA() ({ KArgs p_ = (KArgs)__builtin_amdgcn_kernarg_segment_ptr(); asm volatile("" : "+s"(p_)); p_; })
#define WSP(off) (KA()->ws + (off))

__device__ __forceinline__ void convert_layer(KArgs a, int layer, LAS unsigned char* lds, int wid, int lane) {
    LAS float* scr = (LAS float*)(lds + wid * 8448);
    bf16_t* WB = (bf16_t*)(a->ws + WS_WB);
    const int gw = blockIdx.x * 8 + wid, NGW = gridDim.x * 8;
    constexpr int I_IN = 16 * 208, I_AO = 8 * 32, I_RO = 16 * 32, I_WO = 16 * 32, I_UP = 16 * 128, I_DN = 64 * 32, I_PG = 16 * 32, I_PP = 4 * 32;
    constexpr int NITEMS = I_IN + I_AO + I_RO + I_WO + I_UP + I_DN + I_PG + I_PP;
    for (int it = gw; it < NITEMS; it += NGW) {
        int r = it;
        if (r < I_IN) { transpose_item<true>(a->in[2] + (size_t)layer * 1024 * 6656, 1024, 6656, a->in[11] + layer * 1024, WB + WB_IN, scr, r, lane); continue; } r -= I_IN;
        if (r < I_AO) { transpose_item<false>(a->in[3] + (size_t)layer * 512 * 1024, 512, 1024, nullptr, WB + WB_AO, scr, r, lane); continue; } r -= I_AO;
        if (r < I_RO) { transpose_item<false>(a->in[4] + (size_t)layer * 1024 * 1024, 1024, 1024, nullptr, WB + WB_RO, scr, r, lane); continue; } r -= I_RO;
        if (r < I_WO) { transpose_item<false>(a->in[5] + (size_t)layer * 1024 * 1024, 1024, 1024, nullptr, WB + WB_WO, scr, r, lane); continue; } r -= I_WO;
        if (r < I_UP) { transpose_item<false>(a->in[6] + (size_t)layer * 1024 * 4096, 1024, 4096, a->in[13] + layer * 1024, WB + WB_UP, scr, r, lane); continue; } r -= I_UP;
        if (r < I_DN) { transpose_item<false>(a->in[7] + (size_t)layer * 4096 * 1024, 4096, 1024, nullptr, WB + WB_DN, scr, r, lane); continue; } r -= I_DN;
        if (r < I_PG) { transpose_item<false>(a->in[8] + (size_t)layer * 1024 * 1024, 1024, 1024, nullptr, WB + WB_PG, scr, r, lane); continue; } r -= I_PG;
        transpose_item<false>(a->in[9] + (size_t)layer * 256 * 1024, 256, 1024, nullptr, WB + WB_PP, scr, r, lane);
    }
    const f32x4* ps = (const f32x4*)(a->in[1] + (size_t)layer * M * PLE); u32x4* pd = (u32x4*)(a->ws + WS_PB);
    const int gt = blockIdx.x * 512 + threadIdx.x, NT = gridDim.x * 512;
    for (int i = gt; i < M * PLE / 8; i += NT) { const f32x4 x0 = ps[2 * i], x1 = ps[2 * i + 1];
        u32x4 w; w.x = cvt_pk_bf16(x0[0], x0[1]); w.y = cvt_pk_bf16(x0[2], x0[3]); w.z = cvt_pk_bf16(x1[0], x1[1]); w.w = cvt_pk_bf16(x1[2], x1[3]); pd[i] = w; }
}

__device__ __forceinline__ void sincos_acc(float xf, float& c, float& s) {
    const double x = (double)xf; const double k = rint(x * 0.15915494309189535);
    double r = fma(-k, 6.283185307179586, x); r = fma(-k, 2.4492935982947064e-16, r);
    const double r2 = r * r;
    double sp = 1.0, cp = 1.0;
#pragma unroll
    for (int i = 13; i >= 1; --i) { sp = 1.0 - sp * r2 / (double)((2 * i) * (2 * i + 1)); cp = 1.0 - cp * r2 / (double)((2 * i - 1) * (2 * i)); }
    s = (float)(r * sp); c = (float)cp;
}
__device__ __forceinline__ void build_tables(KArgs a) {
    f32x2* tabA = (f32x2*)(a->ws + WS_TABA); f32x2* tabR = (f32x2*)(a->ws + WS_TABR);
    const int gt = blockIdx.x * 512 + threadIdx.x, NT = gridDim.x * 512;
    for (int e = gt; e < 4096 * 40; e += NT) {
        const int pos = e / 40, j = e % 40; float inv;
        if (j < 8) inv = (float)exp2(-(double)j * 0.125 * 18.931568569324174);
        else inv = (float)exp2(-(double)(j - 8) * 0.03125 * 13.287712379549449);
        const float ang = (float)pos * inv; float c, s; sincos_acc(ang, c, s);
        if (j < 8) tabA[pos * 8 + j] = (f32x2){c, s}; else tabR[pos * 32 + (j - 8)] = (f32x2){c, s};
    }
}

__device__ __forceinline__ void row_pass(const float* x0, float* fout, const bf16_t* Y, int ldy, const float* part, const float* gain, const bf16_t* G, int ldg,
                                         bf16_t* hb, float* rs, int wid, int lane) {
    const int gw = blockIdx.x * 8 + wid, NGW = gridDim.x * 8;
    for (int row = gw; row < M; row += NGW) {
        float rsy = 0.f;
        if (Y) { float pz = (lane < 16) ? part[(size_t)row * 16 + lane] : 0.f; pz = wave_sum(pz); rsy = 1.0f / sqrtf(pz * (1.0f / D) + NORM_EPS); }
        float ss = 0.f;
#pragma unroll
        for (int j = 0; j < 4; ++j) {
            const int col = 4 * lane + 256 * j;
            f32x4 h;
            if (x0) h = *(const f32x4*)(x0 + (size_t)row * D + col);
            else { const u32x2 hw = *(const u32x2*)(hb + (size_t)row * D + col); h = (f32x4){bflo(hw.x), bfhi(hw.x), bflo(hw.y), bfhi(hw.y)}; }
            if (Y) {
                const u32x2 yw = *(const u32x2*)(Y + (size_t)row * ldy + col); const f32x4 gn = *(const f32x4*)(gain + col);
                f32x4 y = (f32x4){bflo(yw.x), bfhi(yw.x), bflo(yw.y), bfhi(yw.y)};
                y = y * rsy * gn;
                if (G) { const u32x2 gw2 = *(const u32x2*)(G + (size_t)row * ldg + col); y = y * (f32x4){bflo(gw2.x), bfhi(gw2.x), bflo(gw2.y), bfhi(gw2.y)}; }
                h = h + y;
            }
            if (fout) *(f32x4*)(fout + (size_t)row * D + col) = h;
            u32x2 o; o.x = cvt_pk_bf16(h[0], h[1]); o.y = cvt_pk_bf16(h[2], h[3]); *(u32x2*)(hb + (size_t)row * D + col) = o;
            ss += (h[0] * h[0] + h[1] * h[1]) + (h[2] * h[2] + h[3] * h[3]);
        }
        ss = wave_sum(ss);
        if (lane == 0) rs[row] = 1.0f / sqrtf(ss * (1.0f / D) + NORM_EPS);
    }
}

__device__ __forceinline__ void attn_phase(LAS unsigned char* lds, bf16_t* P, bf16_t* Od, int ldo, int wid, int lane) {
    const int n = lane & 15, g = lane >> 4;
    LAS unsigned char* vb = lds + wid * 9216;
    const unsigned troff = (unsigned)((4 * g + ((lane & 15) >> 2)) * 144 + (lane & 3) * 8);
    for (int T = blockIdx.x * 8 + wid; T < 16384; T += gridDim.x * 8) {
        const int c = T & 15, blk = (T >> 4) & 15, bh = T >> 8, h = bh & 7, b = bh >> 3;
        const size_t rowbase = (size_t)b * SEQ;
        bf16_t* Pq = P + (rowbase + blk * 256 + c + 16 * n) * LDP + h * 64;
        const bf16x8 qf0 = *(const bf16x8*)(Pq + C_QA + 8 * g), qf1 = *(const bf16x8*)(Pq + C_QA + 32 + 8 * g);
        const bf16_t* Pb = P + rowbase * LDP + h * 64;
        bf16x8 kn[2][2]; u32x4 vn[4];
#define GRP(pi, sh, cr, kbase, iq0, iqs) int sh, cr, kbase, iq0, iqs; \
        if ((pi) < 5) { sh = 4; cr = c; kbase = blk * 16 - 64 + 32 * (pi); iq0 = blk * 16; iqs = 1; } \
        else if ((pi) < 11) { sh = 2; cr = c & 3; kbase = blk * 64 + (c >> 2) - 64 + 32 * ((pi) - 5); iq0 = blk * 64 + (c >> 2); iqs = 4; } \
        else { sh = 0; cr = 0; kbase = blk * 256 + c - 64 + 32 * ((pi) - 11); iq0 = blk * 256 + c; iqs = 16; }
#define LOADPAIR(pi) do { GRP(pi, sh_, cr_, kb_, iq0_, iqs_); (void)iq0_; (void)iqs_; const int L_ = SEQ >> sh_; \
        _Pragma("unroll") for (int t = 0; t < 2; ++t) { int ik = kb_ + 16 * t + n; ik = ik < 0 ? 0 : (ik >= L_ ? L_ - 1 : ik); const bf16_t* kp = Pb + (size_t)(cr_ + (ik << sh_)) * LDP + C_KA; \
            kn[t][0] = *(const bf16x8*)(kp + 8 * g); kn[t][1] = *(const bf16x8*)(kp + 32 + 8 * g); } \
        _Pragma("unroll") for (int x = 0; x < 4; ++x) { int ik = kb_ + (lane >> 3) + 8 * x; ik = ik < 0 ? 0 : (ik >= L_ ? L_ - 1 : ik); \
            vn[x] = *(const u32x4*)(Pb + (size_t)(cr_ + (ik << sh_)) * LDP + C_VA + (lane & 7) * 8); } } while (0)
        LOADPAIR(0);
        float mrun = -1e30f, lrun = 0.f; f32x4 ot[4];
#pragma unroll
        for (int t = 0; t < 4; ++t) ot[t] = (f32x4){0.f, 0.f, 0.f, 0.f};
        for (int pi = 0; pi < 23; ++pi) {
            bf16x8 kc[2][2]; u32x4 vc[4];
#pragma unroll
            for (int t = 0; t < 2; ++t) { kc[t][0] = kn[t][0]; kc[t][1] = kn[t][1]; }
#pragma unroll
            for (int x = 0; x < 4; ++x) vc[x] = vn[x];
            if (pi + 1 < 23) LOADPAIR(pi + 1);
            GRP(pi, sh, cr, kbase, iq0, iqs); (void)cr;
            const int L = SEQ >> sh, iqn = iq0 + iqs * n;
            LAS unsigned char* vbuf = vb + (pi & 1) * 4608;
#pragma unroll
            for (int x = 0; x < 4; ++x) *(LAS u32x4*)(vbuf + ((lane >> 3) + 8 * x) * 144 + (lane & 7) * 16) = vc[x];
            f32x4 s0 = (f32x4){0.f, 0.f, 0.f, 0.f}, s1 = (f32x4){0.f, 0.f, 0.f, 0.f};
            s0 = __builtin_amdgcn_mfma_f32_16x16x32_bf16(kc[0][0], qf0, s0, 0, 0, 0); s0 = __builtin_amdgcn_mfma_f32_16x16x32_bf16(kc[0][1], qf1, s0, 0, 0, 0);
            s1 = __builtin_amdgcn_mfma_f32_16x16x32_bf16(kc[1][0], qf0, s1, 0, 0, 0); s1 = __builtin_amdgcn_mfma_f32_16x16x32_bf16(kc[1][1], qf1, s1, 0, 0, 0);
            float tmax = -1e30f; bool ok0[4], ok1[4];
#pragma unroll
            for (int i = 0; i < 4; ++i) {
                const int ik0 = kbase + 4 * g + i, ik1 = ik0 + 16; const int d0 = iqn - ik0, d1 = iqn - ik1;
                ok0[i] = (ik0 >= 0) && (ik0 < L) && (d0 <= 64) && (d0 >= -64); ok1[i] = (ik1 >= 0) && (ik1 < L) && (d1 <= 64) && (d1 >= -64);
                if (ok0[i]) tmax = fmaxf(tmax, s0[i]); if (ok1[i]) tmax = fmaxf(tmax, s1[i]);
            }
            tmax = fmaxf(tmax, __shfl_xor(tmax, 16)); tmax = fmaxf(tmax, __shfl_xor(tmax, 32));
            const float mnew = fmaxf(mrun, tmax), alpha = __expf(mrun - mnew);
            f32x4 p0, p1; float ps = 0.f;
#pragma unroll
            for (int i = 0; i < 4; ++i) { p0[i] = ok0[i] ? __expf(s0[i] - mnew) : 0.f; p1[i] = ok1[i] ? __expf(s1[i] - mnew) : 0.f; ps += p0[i] + p1[i]; }
            lrun = lrun * alpha + ps; mrun = mnew;
#pragma unroll
            for (int t = 0; t < 4; ++t) ot[t] = ot[t] * alpha;
            const bf16x8 pf = pack8(p0, p1);
            asm volatile("" ::: "memory");
#pragma unroll
            for (int t = 0; t < 4; ++t) {
                const s16x4 lo = tr_read(vbuf + troff + t * 32), hi = tr_read(vbuf + troff + 16 * 144 + t * 32);
                ot[t] = __builtin_amdgcn_mfma_f32_16x16x32_bf16(cat8(lo, hi), pf, ot[t], 0, 0, 0);
            }
            asm volatile("" ::: "memory");
        }
#undef LOADPAIR
#undef GRP
        float l = lrun; l += __shfl_xor(l, 16); l += __shfl_xor(l, 32);
        const float inv = 1.0f / l;
#pragma unroll
        for (int t = 0; t < 4; ++t) { u32x2 o; o.x = cvt_pk_bf16(ot[t][0] * inv, ot[t][1] * inv); o.y = cvt_pk_bf16(ot[t][2] * inv, ot[t][3] * inv);
            *(u32x2*)(Od + (rowbase + blk * 256 + c + 16 * n) * ldo + h * 64 + 16 * t + 4 * g) = o; }
    }
}

__device__ __forceinline__ void ret_kv_phase(LAS unsigned char* lds, const bf16_t* P, bf16_t* KV, const float* dl, int tid, int wid, int lane) {
    constexpr int KF = 0, KB = 18432, VO = 36864;
    const int g = lane >> 4, li = lane & 15, trq = li >> 2, trp = li & 3;
    for (int unit = blockIdx.x; unit < 2048; unit += gridDim.x) {
        const int bh = unit >> 5, nn = unit & 31, b = bh >> 3, h = bh & 7;
        const float lgf = logsig(dl[h]), lgb = logsig(dl[8 + h]);
        const size_t row0 = (size_t)b * SEQ + nn * 128;
#pragma unroll
        for (int x = 0; x < 2; ++x) { const int q = tid + 512 * x, R = q >> 3, pc = q & 7;
            const u32x4 w = *(const u32x4*)(P + (row0 + R) * LDP + C_KR + h * 64 + pc * 8);
            const float zf = __builtin_amdgcn_exp2f(lgf * 1.4426950408889634f * (float)(127 - R)), zb = __builtin_amdgcn_exp2f(lgb * 1.4426950408889634f * (float)R);
            *(LAS u32x4*)(lds + KF + R * 144 + pc * 16) = scale8(w, zf); *(LAS u32x4*)(lds + KB + R * 144 + pc * 16) = scale8(w, zb); }
#pragma unroll
        for (int x = 0; x < 4; ++x) { const int q = tid + 512 * x, R = q >> 4, pc = q & 15;
            *(LAS u32x4*)(lds + VO + R * 272 + pc * 16) = *(const u32x4*)(P + (row0 + R) * LDP + C_VR + h * 128 + pc * 8); }
        __syncthreads();
        f32x4 acc[8];
#pragma unroll
        for (int i = 0; i < 8; ++i) acc[i] = (f32x4){0.f, 0.f, 0.f, 0.f};
#pragma unroll
        for (int ks = 0; ks < 4; ++ks) {
            const int tr0 = 32 * ks + 8 * g + trq;
            const bf16x8 af = cat8(tr_read(lds + VO + tr0 * 272 + (16 * wid + 4 * trp) * 2), tr_read(lds + VO + (tr0 + 4) * 272 + (16 * wid + 4 * trp) * 2));
#pragma unroll
            for (int dkt = 0; dkt < 8; ++dkt) {
                const int ko = (dkt < 4 ? KF : KB) + (16 * (dkt & 3) + 4 * trp) * 2;
                const bf16x8 bf = cat8(tr_read(lds + ko + tr0 * 144), tr_read(lds + ko + (tr0 + 4) * 144));
                acc[dkt] = __builtin_amdgcn_mfma_f32_16x16x32_bf16(af, bf, acc[dkt], 0, 0, 0);
            }
        }
        bf16_t* KVu = KV + (size_t)unit * 16384;
#pragma unroll
        for (int dkt = 0; dkt < 8; ++dkt) { u32x2 o; o.x = cvt_pk_bf16(acc[dkt][0], acc[dkt][1]); o.y = cvt_pk_bf16(acc[dkt][2], acc[dkt][3]);
            *(u32x2*)(KVu + (dkt >> 2) * 8192 + (16 * (dkt & 3) + li) * 128 + 16 * wid + 4 * g) = o; }
        __syncthreads();
    }
}
__device__ __forceinline__ void ret_scan_phase(bf16_t* KV, const float* dl, int tid) {
    const int gt = blockIdx.x * 512 + tid, NT = gridDim.x * 512;
    for (int e = gt; e < 64 * 8192; e += NT) {
        const int bh = e >> 13, pp = e & 8191, dir = pp >> 12, h = bh & 7;
        const float G = expf(128.0f * logsig(dl[dir * 8 + h]));
        unsigned* base = (unsigned*)KV + (size_t)bh * 32 * 8192 + pp;
        unsigned w[32];
#pragma unroll
        for (int st = 0; st < 32; ++st) w[st] = base[(size_t)st * 8192];
        float s0 = 0.f, s1 = 0.f;
        if (dir == 0) {
#pragma unroll
            for (int st = 0; st < 32; ++st) { const unsigned o = cvt_pk_bf16(s0, s1); s0 = s0 * G + bflo(w[st]); s1 = s1 * G + bfhi(w[st]); w[st] = o; }
        } else {
#pragma unroll
            for (int st = 31; st >= 0; --st) { const unsigned o = cvt_pk_bf16(s0, s1); s0 = s0 * G + bflo(w[st]); s1 = s1 * G + bfhi(w[st]); w[st] = o; }
        }
#pragma unroll
        for (int st = 0; st < 32; ++st) base[(size_t)st * 8192] = w[st];
    }
}
__device__ __forceinline__ void ret_out_phase(LAS unsigned char* lds, bf16_t* P, int ocol, const bf16_t* KV, const float* dl, int tid, int wid, int lane) {
    constexpr int KO = 0, VO = 18432, SF = 53248, SB = 70656;
    const int g = lane >> 4, li = lane & 15, trq = li >> 2, trp = li & 3;
    for (int unit = blockIdx.x; unit < 2048; unit += gridDim.x) {
        const int bh = unit >> 5, nn = unit & 31, b = bh >> 3, h = bh & 7;
        const float lgf = logsig(dl[h]), lgb = logsig(dl[8 + h]);
        const size_t row0 = (size_t)b * SEQ + nn * 128;
        const bf16_t* KVu = KV + (size_t)unit * 16384;
#pragma unroll
        for (int x = 0; x < 2; ++x) { const int q = tid + 512 * x, R = q >> 3, pc = q & 7;
            *(LAS u32x4*)(lds + KO + R * 144 + pc * 16) = *(const u32x4*)(P + (row0 + R) * LDP + C_KR + h * 64 + pc * 8); }
#pragma unroll
        for (int x = 0; x < 4; ++x) { const int q = tid + 512 * x, R = q >> 4, pc = q & 15;
            *(LAS u32x4*)(lds + VO + R * 272 + pc * 16) = *(const u32x4*)(P + (row0 + R) * LDP + C_VR + h * 128 + pc * 8); }
#pragma unroll
        for (int x = 0; x < 4; ++x) { const int q = tid + 512 * x, dir = q >> 10, R = (q >> 4) & 63, pc = q & 15;
            *(LAS u32x4*)(lds + (dir ? SB : SF) + R * 272 + pc * 16) = *(const u32x4*)(KVu + dir * 8192 + R * 128 + pc * 8); }
        const int a = 16 * wid + li;
        bf16_t* Pr = P + (row0 + a) * LDP;
        const u32x4 q0 = *(const u32x4*)(Pr + C_QR + h * 64 + 8 * g), q1 = *(const u32x4*)(Pr + C_QR + h * 64 + 32 + 8 * g);
        const float lgf2 = lgf * 1.4426950408889634f, lgb2 = lgb * 1.4426950408889634f;
        const float xf = __builtin_amdgcn_exp2f(lgf2 * (float)(a + 1)), xb = __builtin_amdgcn_exp2f(lgb2 * (float)(128 - a));
        const bf16x8 qr0 = __builtin_bit_cast(bf16x8, q0), qr1 = __builtin_bit_cast(bf16x8, q1);
        const bf16x8 qf0 = __builtin_bit_cast(bf16x8, scale8(q0, xf)), qf1 = __builtin_bit_cast(bf16x8, scale8(q1, xf));
        const bf16x8 qb0 = __builtin_bit_cast(bf16x8, scale8(q0, xb)), qb1 = __builtin_bit_cast(bf16x8, scale8(q1, xb));
        __syncthreads();
        bf16x8 pf[4];
#pragma unroll
        for (int kp = 0; kp < 4; ++kp) {
            f32x4 st[2];
#pragma unroll
            for (int t = 0; t < 2; ++t) {
                const int kt = 2 * kp + t;
                const bf16x8 k0 = *(const LAS bf16x8*)(lds + KO + (16 * kt + li) * 144 + 16 * g), k1 = *(const LAS bf16x8*)(lds + KO + (16 * kt + li) * 144 + 64 + 16 * g);
                f32x4 s = (f32x4){0.f, 0.f, 0.f, 0.f};
                s = __builtin_amdgcn_mfma_f32_16x16x32_bf16(k0, qr0, s, 0, 0, 0); s = __builtin_amdgcn_mfma_f32_16x16x32_bf16(k1, qr1, s, 0, 0, 0);
#pragma unroll
                for (int i = 0; i < 4; ++i) { const int key = 16 * kt + 4 * g + i, d = a - key; const float w = __builtin_amdgcn_exp2f(d >= 0 ? lgf2 * (float)d : lgb2 * (float)(-d)); s[i] *= w; }
                st[t] = s;
            }
            pf[kp] = pack8(st[0], st[1]);
        }
        f32x4 acc[8];
#pragma unroll
        for (int dt = 0; dt < 8; ++dt) {
            f32x4 c = (f32x4){0.f, 0.f, 0.f, 0.f};
            const int co = (16 * dt + 4 * trp) * 2;
#pragma unroll
            for (int kp = 0; kp < 4; ++kp) {
                const bf16x8 vf = cat8(tr_read(lds + VO + (32 * kp + 4 * g + trq) * 272 + co), tr_read(lds + VO + (32 * kp + 16 + 4 * g + trq) * 272 + co));
                c = __builtin_amdgcn_mfma_f32_16x16x32_bf16(vf, pf[kp], c, 0, 0, 0);
            }
#pragma unroll
            for (int ks = 0; ks < 2; ++ks) {
                const int r0 = 32 * ks + 8 * g + trq;
                const bf16x8 sf = cat8(tr_read(lds + SF + r0 * 272 + co), tr_read(lds + SF + (r0 + 4) * 272 + co));
                c = __builtin_amdgcn_mfma_f32_16x16x32_bf16(sf, ks ? qf1 : qf0, c, 0, 0, 0);
                const bf16x8 sb = cat8(tr_read(lds + SB + r0 * 272 + co), tr_read(lds + SB + (r0 + 4) * 272 + co));
                c = __builtin_amdgcn_mfma_f32_16x16x32_bf16(sb, ks ? qb1 : qb0, c, 0, 0, 0);
            }
            acc[dt] = c;
        }
        float s = 0.f;
#pragma unroll
        for (int dt = 0; dt < 8; ++dt) s += (acc[dt][0] + acc[dt][1]) + (acc[dt][2] + acc[dt][3]);
        s += __shfl_xor(s, 16); s += __shfl_xor(s, 32);
        const float mu = s * (1.0f / 128.0f); float vq = 0.f;
#pragma unroll
        for (int dt = 0; dt < 8; ++dt) { const f32x4 d = acc[dt] - mu; vq += (d[0] * d[0] + d[1] * d[1]) + (d[2] * d[2] + d[3] * d[3]); }
        vq += __shfl_xor(vq, 16); vq += __shfl_xor(vq, 32);
        const float rstd = 1.0f / sqrtf(vq * (1.0f / 128.0f) + GN_EPS);
#pragma unroll
        for (int dt = 0; dt < 8; ++dt) {
            const int col = h * 128 + 16 * dt + 4 * g;
            const u32x2 gw = *(const u32x2*)(Pr + C_GR + col);
            const f32x4 y = (acc[dt] - mu) * rstd;
            u32x2 o; o.x = cvt_pk_bf16(y[0] * bflo(gw.x), y[1] * bfhi(gw.x)); o.y = cvt_pk_bf16(y[2] * bflo(gw.y), y[3] * bfhi(gw.y));
            *(u32x2*)(Pr + ocol + col) = o;
        }
        __syncthreads();
    }
}


#define XB_TMO      128
#define XB_XCNT(j)  (256  + 64 * (j))
#define XB_XSUB(j)  (1280 + 64 * (j))
#define XB_XGEN(j)  (2304 + 64 * (j))
#define XB_TOP      3328
#define XB_TOPGEN   3392
#define XCD_BAR_WORDS 3456
#define XB_SPIN_CAP (1u << 22)
__device__ __forceinline__ unsigned xb_ld(unsigned* p)              { return __hip_atomic_load(p, __ATOMIC_RELAXED, __HIP_MEMORY_SCOPE_AGENT); }
__device__ __forceinline__ unsigned xb_add(unsigned* p, unsigned v) { return __hip_atomic_fetch_add(p, v, __ATOMIC_RELAXED, __HIP_MEMORY_SCOPE_AGENT); }
__device__ __forceinline__ unsigned xb_xcc_id() { return (unsigned)__builtin_amdgcn_s_getreg((3 << 11) | 20) & 0xFu; }
#define XB_SPIN(cond, bar) do { unsigned _sp = 0; while (cond) { __builtin_amdgcn_s_sleep(1); \
    if ((++_sp & 255u) == 0u) { if (xb_ld(&(bar)[XB_TMO])) break; if (_sp > XB_SPIN_CAP) { atomicAdd(&(bar)[XB_TMO], 1u); break; } } } } while (0)
__device__ __forceinline__ void xcd_barrier_complete(unsigned* bar, unsigned x, unsigned& nloc, unsigned& nx) {
    const unsigned G = gridDim.x * gridDim.y * gridDim.z;
    unsigned sum, cnt, mine, sp = 0u;
    for (;;) {
        sum = 0u; cnt = 0u; mine = 0u;
#pragma unroll
        for (unsigned j = 0; j < 16; ++j) { const unsigned c = xb_ld(&bar[XB_XCNT(j)]); sum += c; cnt += (c > 0u) ? 1u : 0u; mine = (j == x) ? c : mine; }
        if (sum == G) break;
        __builtin_amdgcn_s_sleep(1);
        if ((++sp & 255u) == 0u) { if (xb_ld(&bar[XB_TMO])) break; if (sp > XB_SPIN_CAP) { atomicAdd(&bar[XB_TMO], 1u); break; } }
    }
    nloc = mine > 0u ? mine : 1u; nx = cnt > 0u ? cnt : 1u;
}
__device__ __forceinline__ void xcd_barrier(unsigned* bar, unsigned x, volatile LAS unsigned* st) {
    asm volatile("s_waitcnt vmcnt(0)" ::: "memory");
    __syncthreads();
    if (threadIdx.x == 0) {
        __builtin_amdgcn_s_waitcnt(0);
        unsigned nloc = st[0], nx = st[1];
        if (nloc == 0u) { xcd_barrier_complete(bar, x, nloc, nx); st[0] = nloc; st[1] = nx; }
        const unsigned old = xb_add(&bar[XB_XSUB(x)], 1u);
        const unsigned gen = old / nloc;
        if (old + 1u == (gen + 1u) * nloc) {
            __builtin_amdgcn_fence(__ATOMIC_RELEASE, "agent");
            asm volatile("s_waitcnt vmcnt(0)" ::: "memory");
            const unsigned og = xb_add(&bar[XB_TOP], 1u);
            const unsigned tg = og / nx;
            if (og + 1u == (tg + 1u) * nx) xb_add(&bar[XB_TOPGEN], 1u);
            else XB_SPIN(xb_ld(&bar[XB_TOPGEN]) == tg, bar);
            __builtin_amdgcn_fence(__ATOMIC_ACQUIRE, "agent");
            xb_add(&bar[XB_XGEN(x)], 1u);
            asm volatile("s_waitcnt vmcnt(0)" ::: "memory");
        } else {
            XB_SPIN(xb_ld(&bar[XB_XGEN(x)]) == gen, bar);
            __builtin_amdgcn_fence(__ATOMIC_ACQUIRE, "agent");
            asm volatile("s_waitcnt vmcnt(0)" ::: "memory");
        }
    }
    __syncthreads();
}

#ifndef DBG_STOP
#define DBG_STOP 0
#endif
__device__ __forceinline__ void dbg_dump(float* out, const bf16_t* s0, int ld0, int w0, const bf16_t* s1, int ld1, int w1) {
    const int gt = blockIdx.x * 512 + threadIdx.x, NT = gridDim.x * 512;
    for (int e = gt; e < M * D; e += NT) { const int row = e >> 10, c = e & 1023; float v = 0.f;
        for (int j = 0; c + 1024 * j < w0; ++j) v += bflo((unsigned)s0[(size_t)row * ld0 + c + 1024 * j]);
        if (s1) for (int j = 0; c + 1024 * j < w1; ++j) v += bflo((unsigned)s1[(size_t)row * ld1 + c + 1024 * j]);
        out[e] = v; }
}
#define DBG(k, s0, ld0, w0, s1, ld1, w1) do { if (DBG_STOP == (k) && layer == 0) { dbg_dump(hout, s0, ld0, w0, s1, ld1, w1); return; } } while (0)
#define DBGRET(k) do { if (DBG_STOP == (k) && layer == 0) return; } while (0)
#define GRID_SYNC() xcd_barrier((unsigned*)WSP(WS_CTL), xcc_id, (volatile LAS unsigned*)(lds + LDS_BYTES - 64))
__global__ void __launch_bounds__(512, 2) fwd_kernel(Args a) {
    extern __shared__ __attribute__((aligned(16))) unsigned char lds_raw[];
    LAS unsigned char* lds = (LAS unsigned char*)lds_raw;
    cg::grid_group grid = cg::this_grid();
    const unsigned xcc_id = xb_xcc_id();
    if (threadIdx.x < 16) ((LAS unsigned*)(lds + LDS_BYTES - 64))[threadIdx.x] = 0u;
    __syncthreads();
    if (threadIdx.x == 0) (void)xb_add((unsigned*)WSP(WS_CTL) + XB_XCNT(xcc_id), 1u);
    grid.sync();
    const int G = gridDim.x, cb = blockIdx.x;
#define WB ((bf16_t*)WSP(WS_WB))
#define tabA ((const f32x2*)WSP(WS_TABA))
#define tabR ((const f32x2*)WSP(WS_TABR))
#define rs ((float*)WSP(WS_RS))
#define part ((float*)WSP(WS_PART))
#define hb ((bf16_t*)WSP(WS_HB))
#define pb ((bf16_t*)WSP(WS_PB))
#define KV ((bf16_t*)WSP(WS_KV))
#define P ((bf16_t*)WSP(WS_PROJ))
#define hout (KA()->out)

#ifndef PHM
#define PHM 0xffff
#endif
#ifndef DUP
#define DUP 0
#endif
#define REP(bit) _Pragma("unroll 1") for (int rep_ = 0; rep_ < ((DUP & (bit)) ? 2 : 1); ++rep_)
    { const int tid = threadIdx.x, wid = __builtin_amdgcn_readfirstlane(tid >> 6), lane = tid & 63; (void)tid;
    if (PHM & 1) build_tables(KA());
    if (PHM & 2) convert_layer(KA(), 0, lds, wid, lane);
    if (PHM & 4) row_pass(KA()->in[0], nullptr, nullptr, 0, nullptr, nullptr, nullptr, 0, hb, rs, wid, lane); }
    GRID_SYNC();

#pragma unroll 1
    for (int layer = 0; layer < DEPTH; ++layer) {
        const float* dl = KA()->in[10] + layer * 16;
        if (DUP & 512) { _Pragma("unroll 1") for (int xs = 0; xs < 20; ++xs) GRID_SYNC(); }
        int tid = threadIdx.x; asm volatile("" : "+v"(tid));
        const int wid = __builtin_amdgcn_readfirstlane(tid >> 6), lane = tid & 63;
        REP(1) if (PHM & 8) { pg8::Gemm g{hb, WB + WB_IN, M, 4608, 1024, 1024, 1024}; pg8::StaticOrder S; S.init(M, 4608, G, cb);
          pg8::EpiProj E{P, rs, tabA, tabR}; pg8::gemm_phase<pg8::EpiProj>(lds, g, S, E); }
        GRID_SYNC();
        DBG(1, P, LDP, 4608, nullptr, 0, 0);
        if (DUP & 128) { attn_phase(lds, P, KV, 512, wid, lane); GRID_SYNC(); }
        if (PHM & 16) attn_phase(lds, P, P, LDP, wid, lane);
        __syncthreads();
        REP(64) if (PHM & 32) ret_kv_phase(lds, P, KV, dl, tid, wid, lane);
        GRID_SYNC();
        DBG(2, P, LDP, 512, KV, 1024, 1024);
        if (PHM & 64) ret_scan_phase(KV, dl, tid);
        GRID_SYNC();
        DBG(3, KV, 1024, 1024, nullptr, 0, 0);
        REP(256) if (PHM & 128) ret_out_phase(lds, P, ((DUP & 256) && rep_ == 0) ? C_S1 : C_VR, KV, dl, tid, wid, lane);
        GRID_SYNC();
        DBG(4, P + C_VR, LDP, 1024, nullptr, 0, 0);
        if (PHM & 256) { pg8::StaticOrder S; S.init(M, 1024, G, cb);
          REP(2) { pg8::Gemm g{hb, WB + WB_GA, M, 1024, 1024, 1024, 1024}; pg8::EpiAct<0> E{P + C_S1, LDP, rs}; pg8::gemm_phase<pg8::EpiAct<0>>(lds, g, S, E); }
          { pg8::Gemm g{P + C_QA, WB + WB_AO, M, 1024, 512, LDP, 512}; pg8::EpiMulAdd E{P + C_S1, nullptr, LDP}; pg8::gemm_phase<pg8::EpiMulAdd>(lds, g, S, E); }
          REP(2) { pg8::Gemm g{hb, WB + WB_GB, M, 1024, 1024, 1024, 1024}; pg8::EpiAct<0> E{P + C_S2, LDP, rs}; pg8::gemm_phase<pg8::EpiAct<0>>(lds, g, S, E); }
          { pg8::Gemm g{P + C_VR, WB + WB_RO, M, 1024, 1024, LDP, 1024}; pg8::EpiMulAdd E{P + C_S2, P + C_S1, LDP}; pg8::gemm_phase<pg8::EpiMulAdd>(lds, g, S, E); } }
        GRID_SYNC();
        DBG(5, P + C_S2, LDP, 1024, nullptr, 0, 0);
        REP(4) if (PHM & 512) { pg8::Gemm g{P + C_S2, WB + WB_WO, M, 1024, 1024, LDP, 1024}; pg8::StaticOrder S; S.init(M, 1024, G, cb);
          pg8::EpiY E{P + C_Y, LDP, part}; pg8::gemm_phase<pg8::EpiY>(lds, g, S, E); }
        GRID_SYNC();
        DBG(6, P + C_Y, LDP, 1024, nullptr, 0, 0);
        row_pass(nullptr, nullptr, P + C_Y, LDP, part, KA()->in[12] + layer * D, nullptr, 0, hb, rs, wid, lane);
        GRID_SYNC();
        DBGRET(7);
        REP(8) if (PHM & 1024) { pg8::Gemm g{hb, WB + WB_UP, M, FF, 1024, 1024, 1024}; pg8::StaticOrder S; S.init(M, FF, G, cb);
          pg8::EpiAct<1> E{P, FF, rs}; pg8::gemm_phase<pg8::EpiAct<1>>(lds, g, S, E); }
        GRID_SYNC();
        DBG(8, P, FF, 4096, nullptr, 0, 0);
        REP(16) if (PHM & 2048) { pg8::Gemm g{P, WB + WB_DN, M, 1024, FF, FF, FF}; pg8::StaticOrder S; S.init(M, 1024, G, cb);
          pg8::EpiY E{KV, 1024, part}; pg8::gemm_phase<pg8::EpiY>(lds, g, S, E); }
        GRID_SYNC();
        DBG(9, KV, 1024, 1024, nullptr, 0, 0);
        row_pass(nullptr, nullptr, KV, 1024, part, KA()->in[14] + layer * D, nullptr, 0, hb, rs, wid, lane);
        GRID_SYNC();
        DBGRET(10);
        if (PHM & 4096) { pg8::StaticOrder S; S.init(M, 1024, G, cb);
          REP(32) { pg8::Gemm g{hb, WB + WB_PG, M, 1024, 1024, 1024, 1024}; pg8::EpiAct<0> E{P, 1024, rs}; pg8::gemm_phase<pg8::EpiAct<0>>(lds, g, S, E); }
          REP(32) { pg8::Gemm g{pb, WB + WB_PP, M, 1024, PLE, PLE, PLE}; pg8::EpiY E{KV, 1024, part}; pg8::gemm_phase<pg8::EpiY>(lds, g, S, E); } }
        GRID_SYNC();
        DBG(11, P, 1024, 1024, KV, 1024, 1024);
        row_pass(nullptr, layer == DEPTH - 1 ? hout : nullptr, KV, 1024, part, KA()->in[15] + layer * D, P, 1024, hb, rs, wid, lane);
        if (layer + 1 < DEPTH) convert_layer(KA(), layer + 1, lds, wid, lane);
        GRID_SYNC();
        DBGRET(12);
    }
}
#undef WB
#undef tabA
#undef tabR
#undef rs
#undef part
#undef hb
#undef pb
#undef KV
#undef P
#undef hout

extern "C" void kernel_launch(void* const* d_in, const int* in_sizes, int n_in, void* d_out, int out_size, void* d_ws, size_t ws_size, hipStream_t stream) {
    static int grid = 0;
    if (grid == 0) {
        if (n_in != 16 || out_size != M * D || ws_size < WS_END) { fprintf(stderr, "kernel_launch: unexpected shapes/workspace (n_in %d out %d ws %zu)\n", n_in, out_size, ws_size); grid = -1; return; }
        int dev = 0, cus = 0, per_cu = 0;
        hipGetDevice(&dev); hipDeviceGetAttribute(&cus, hipDeviceAttributeMultiprocessorCount, dev);
        hipFuncSetAttribute((const void*)fwd_kernel, hipFuncAttributeMaxDynamicSharedMemorySize, LDS_BYTES);
        hipOccupancyMaxActiveBlocksPerMultiprocessor(&per_cu, (const void*)fwd_kernel, 512, LDS_BYTES);
        if (per_cu < 1) per_cu = 1;
        grid = cus * 1;
        (void)hipGetLastError();
    }
    if (grid < 0) return;
    if (hipMemsetAsync((char*)d_ws + WS_CTL, 0, XCD_BAR_WORDS * 4, stream) != hipSuccess) { fprintf(stderr, "memset failed\n"); return; }
    Args a{};
    for (int i = 0; i < 16; ++i) a.in[i] = (const float*)d_in[i];
    a.out = (float*)d_out; a.ws = (unsigned char*)d_ws;
    void* args[] = {&a};
    hipError_t e = hipLaunchCooperativeKernel((const void*)fwd_kernel, dim3(grid), dim3(512), args, LDS_BYTES, stream);
    if (e != hipSuccess) fprintf(stderr, "cooperative launch failed: %s (grid %d)\n", hipGetErrorString(e), grid);
}
```

```cpp
#include <hip/hip_runtime.h>
#include <hip/hip_cooperative_groups.h>
#include <cstdio>
#include <cstdint>
namespace cg = cooperative_groups;

#define LAS __attribute__((address_space(3)))
typedef unsigned short bf16_t;
typedef short bf16x8 __attribute__((ext_vector_type(8)));
typedef short s16x4 __attribute__((ext_vector_type(4)));
typedef short v4i16_t __attribute__((ext_vector_type(4)));
typedef float f32x4 __attribute__((ext_vector_type(4)));
typedef float f32x2 __attribute__((ext_vector_type(2)));
typedef unsigned u32x4 __attribute__((ext_vector_type(4)));
typedef unsigned u32x2 __attribute__((ext_vector_type(2)));

constexpr int M = 32768, D = 1024, SEQ = 4096, DEPTH = 4, FF = 4096, PLE = 256;
constexpr int LDP = 4608;
constexpr int C_QA = 0, C_KA = 512, C_VA = 1024, C_QR = 1536, C_KR = 2048, C_VR = 2560, C_GR = 3584;
constexpr int C_S1 = 512, C_S2 = 1536, C_Y = 3584;
constexpr float NORM_EPS = 1e-6f, GN_EPS = 1e-5f;
constexpr size_t MiB = 1u << 20;
constexpr size_t WS_WB = 0;
constexpr size_t WB_IN = 0, WB_GA = (size_t)4608 * 1024, WB_GB = (size_t)5632 * 1024, WB_AO = (size_t)6656 * 1024, WB_RO = WB_AO + 1024 * 512,
                 WB_WO = WB_RO + 1024 * 1024, WB_UP = WB_WO + 1024 * 1024, WB_DN = WB_UP + 4096 * 1024, WB_PG = WB_DN + 4096 * 1024, WB_PP = WB_PG + 1024 * 1024;
constexpr size_t WS_TABA = 37 * MiB, WS_TABR = WS_TABA + 4096 * 8 * 8;
constexpr size_t WS_CTL = 38 * MiB + 512 * 1024;
constexpr size_t WS_RS = 39 * MiB, WS_PART = 40 * MiB;
constexpr size_t WS_HB = 42 * MiB, WS_PB = 106 * MiB, WS_KV = 122 * MiB, WS_PROJ = 186 * MiB, WS_END = 474 * MiB;
constexpr int LDS_BYTES = 147456;

typedef __bf16 bf16x2_t __attribute__((ext_vector_type(2)));
__device__ __forceinline__ unsigned cvt_pk_bf16(float lo, float hi) { const f32x2 v = {lo, hi}; const bf16x2_t b = __builtin_convertvector(v, bf16x2_t); return __builtin_bit_cast(unsigned, b); }
__device__ __forceinline__ float bflo(unsigned w) { return __uint_as_float(w << 16); }
__device__ __forceinline__ float bfhi(unsigned w) { return __uint_as_float(w & 0xffff0000u); }
__device__ __forceinline__ float sigmoidf_(float x) { return __builtin_amdgcn_rcpf(1.0f + __expf(-x)); }
__device__ __forceinline__ float wave_sum(float v) {
#pragma unroll
    for (int o = 1; o < 64; o <<= 1) v += __shfl_xor(v, o);
    return v;
}
__device__ __forceinline__ float logsig(float x) { return -log1pf(expf(-x)); }
__device__ __forceinline__ s16x4 tr_read(LAS unsigned char* p) { return __builtin_bit_cast(s16x4, __builtin_amdgcn_ds_read_tr16_b64_v4i16((LAS v4i16_t*)p)); }
__device__ __forceinline__ bf16x8 cat8(s16x4 lo, s16x4 hi) { return (bf16x8){lo[0], lo[1], lo[2], lo[3], hi[0], hi[1], hi[2], hi[3]}; }
__device__ __forceinline__ bf16x8 pack8(f32x4 a, f32x4 b) { u32x4 w; w.x = cvt_pk_bf16(a[0], a[1]); w.y = cvt_pk_bf16(a[2], a[3]); w.z = cvt_pk_bf16(b[0], b[1]); w.w = cvt_pk_bf16(b[2], b[3]); return __builtin_bit_cast(bf16x8, w); }
__device__ __forceinline__ u32x4 scale8(u32x4 w, float s) {
    u32x4 o; o.x = cvt_pk_bf16(bflo(w.x) * s, bfhi(w.x) * s); o.y = cvt_pk_bf16(bflo(w.y) * s, bfhi(w.y) * s);
    o.z = cvt_pk_bf16(bflo(w.z) * s, bfhi(w.z) * s); o.w = cvt_pk_bf16(bflo(w.w) * s, bfhi(w.w) * s); return o;
}

namespace pg8 {
constexpr int BM = 256, BK = 64, HALF = 128, HTB = HALF * BK * 2, STAGE_BYTES = 8 * HTB, NXCD = 8, WGM = 8;
__host__ __device__ __forceinline__ int lds_byte(int r, int c) { const int st = (r >> 4) * 2 + (c >> 5), rr = r & 15, cc = c & 31, ob = rr * 64 + cc * 2; return st * 1024 + (ob ^ (((ob >> 9) & 1) << 5)); }
__host__ __device__ __forceinline__ void stage_rc(int b, int& R, int& C) { const int st = b / 1024, sb = b % 1024, swz = sb ^ (((sb >> 9) & 1) << 5); R = (st >> 1) * 16 + swz / 64; C = (st & 1) * 32 + (swz % 64) / 2; }
__host__ __device__ __forceinline__ int perm32(int rho) { const int n = rho >> 4, i = rho & 15; return 8 * (i >> 2) + 4 * n + (i & 3); }
struct Unit { int pm, pn; };
struct Gemm { const bf16_t* A; const bf16_t* Bt; int M, N, K, lda, ldb; };
struct StaticOrder {
    int nM, nN, nwg, G, c;
    __device__ void init(int M_, int N_, int G_, int c_) { nM = M_ / BM; nN = N_ / BM; nwg = nM * nN; G = G_; c = c_; }
    __device__ bool next(int i, Unit& u) const {
        const long L = (long)i * G + c; if (L >= nwg) return false;
        int wgid = (int)L; { const int q = nwg / NXCD, r = nwg % NXCD, xcd = wgid % NXCD, off = wgid / NXCD; wgid = (xcd < r ? xcd * (q + 1) : r * (q + 1) + (xcd - r) * q) + off; }
        const int nig = WGM * nN, gid = wgid / nig, fm = gid * WGM, gsz = (nM - fm) < WGM ? (nM - fm) : WGM;
        u.pm = fm + ((wgid % nig) % gsz); u.pn = (wgid % nig) / gsz; return true;
    }
};
#define EPI_ARGS const f32x4 (&acc)[2][2][4][2], const Unit& u, int wr, int wc, int fr, int fq

struct EpiProj {
    static constexpr bool PERM = true;
    bf16_t* O; const float* rs; const f32x2* tabA; const f32x2* tabR;
    __device__ __forceinline__ void operator()(EPI_ARGS) const {
        const int pn = u.pn; int kind = 0; float sc = 1.f;
        if (pn < 2) { kind = 1; sc = 0.125f * 1.4426950408889634f; } else if (pn < 4) kind = 1; else if (pn < 6) kind = 0; else if (pn < 8) kind = 2; else if (pn < 10) { kind = 2; sc = 0.125f; } else if (pn < 14) kind = 0; else kind = 3;
        const int row0 = u.pm * BM + wr * 64 + fr, colb = pn * BM + wc * 32 + 8 * fq;
#pragma unroll
        for (int ai = 0; ai < 2; ++ai)
#pragma unroll
            for (int m = 0; m < 4; ++m) {
                const int row = row0 + ai * HALF + m * 16; const float r = rs[row] * sc; const int pos = row & (SEQ - 1);
#pragma unroll
                for (int bj = 0; bj < 2; ++bj) {
                    const int c0 = colb + bj * HALF; f32x4 v0 = acc[ai][bj][m][0] * r, v1 = acc[ai][bj][m][1] * r;
                    if (kind == 1 || kind == 2) {
                        const int cm = c0 & 63;
                        if (kind == 2 || cm < 16) {
                            const f32x4* t = (kind == 1) ? (const f32x4*)(tabA + pos * 8 + (cm >> 1)) : (const f32x4*)(tabR + pos * 32 + (cm >> 1));
                            const f32x4 t0 = t[0], t1 = t[1];
                            f32x4 w0, w1;
                            w0[0] = v0[0] * t0[0] - v0[1] * t0[1]; w0[1] = v0[1] * t0[0] + v0[0] * t0[1]; w0[2] = v0[2] * t0[2] - v0[3] * t0[3]; w0[3] = v0[3] * t0[2] + v0[2] * t0[3];
                            w1[0] = v1[0] * t1[0] - v1[1] * t1[1]; w1[1] = v1[1] * t1[0] + v1[0] * t1[1]; w1[2] = v1[2] * t1[2] - v1[3] * t1[3]; w1[3] = v1[3] * t1[2] + v1[2] * t1[3];
                            v0 = w0; v1 = w1;
                        }
                    } else if (kind == 3) {
#pragma unroll
                        for (int j = 0; j < 4; ++j) { v0[j] = v0[j] * sigmoidf_(v0[j]); v1[j] = v1[j] * sigmoidf_(v1[j]); }
                    }
                    u32x4 w; w.x = cvt_pk_bf16(v0[0], v0[1]); w.y = cvt_pk_bf16(v0[2], v0[3]); w.z = cvt_pk_bf16(v1[0], v1[1]); w.w = cvt_pk_bf16(v1[2], v1[3]);
                    *(u32x4*)(O + (size_t)row * LDP + c0) = w;
                }
            }
    }
};
template <int ACT> struct EpiAct {
    static constexpr bool PERM = true;
    bf16_t* O; int ldc; const float* rs;
    __device__ __forceinline__ void operator()(EPI_ARGS) const {
        const int row0 = u.pm * BM + wr * 64 + fr, colb = u.pn * BM + wc * 32 + 8 * fq;
#pragma unroll
        for (int ai = 0; ai < 2; ++ai)
#pragma unroll
            for (int m = 0; m < 4; ++m) {
                const int row = row0 + ai * HALF + m * 16; const float r = rs[row];
#pragma unroll
                for (int bj = 0; bj < 2; ++bj) {
                    f32x4 v0 = acc[ai][bj][m][0] * r, v1 = acc[ai][bj][m][1] * r;
#pragma unroll
                    for (int j = 0; j < 4; ++j) {
                        if (ACT == 0) { v0[j] = sigmoidf_(v0[j]); v1[j] = sigmoidf_(v1[j]); }
                        else { const float a0 = fmaxf(v0[j], 0.f), a1 = fmaxf(v1[j], 0.f); v0[j] = a0 * a0; v1[j] = a1 * a1; }
                    }
                    u32x4 w; w.x = cvt_pk_bf16(v0[0], v0[1]); w.y = cvt_pk_bf16(v0[2], v0[3]); w.z = cvt_pk_bf16(v1[0], v1[1]); w.w = cvt_pk_bf16(v1[2], v1[3]);
                    *(u32x4*)(O + (size_t)row * ldc + colb + bj * HALF) = w;
                }
            }
    }
};
struct EpiMulAdd {
    static constexpr bool PERM = true;
    bf16_t* S; const bf16_t* T; int ld;
    __device__ __forceinline__ void operator()(EPI_ARGS) const {
        const int row0 = u.pm * BM + wr * 64 + fr, colb = u.pn * BM + wc * 32 + 8 * fq;
#pragma unroll
        for (int ai = 0; ai < 2; ++ai)
#pragma unroll
            for (int m = 0; m < 4; ++m) {
                const int row = row0 + ai * HALF + m * 16;
#pragma unroll
                for (int bj = 0; bj < 2; ++bj) {
                    const size_t off = (size_t)row * ld + colb + bj * HALF;
                    const u32x4 s = *(const u32x4*)(S + off); u32x4 t = (u32x4){0u, 0u, 0u, 0u}; if (T) t = *(const u32x4*)(T + off);
                    const f32x4 a0 = acc[ai][bj][m][0], a1 = acc[ai][bj][m][1];
                    u32x4 w;
                    w.x = cvt_pk_bf16(bflo(t.x) + bflo(s.x) * a0[0], bfhi(t.x) + bfhi(s.x) * a0[1]); w.y = cvt_pk_bf16(bflo(t.y) + bflo(s.y) * a0[2], bfhi(t.y) + bfhi(s.y) * a0[3]);
                    w.z = cvt_pk_bf16(bflo(t.z) + bflo(s.z) * a1[0], bfhi(t.z) + bfhi(s.z) * a1[1]); w.w = cvt_pk_bf16(bflo(t.w) + bflo(s.w) * a1[2], bfhi(t.w) + bfhi(s.w) * a1[3]);
                    *(u32x4*)(S + off) = w;
                }
            }
    }
};
struct EpiY {
    static constexpr bool PERM = true;
    bf16_t* Y; int ldc; float* part;
    __device__ __forceinline__ void operator()(EPI_ARGS) const {
        const int row0 = u.pm * BM + wr * 64 + fr, colb = u.pn * BM + wc * 32 + 8 * fq;
#pragma unroll
        for (int ai = 0; ai < 2; ++ai)
#pragma unroll
            for (int m = 0; m < 4; ++m) {
                const int row = row0 + ai * HALF + m * 16; float s = 0.f;
#pragma unroll
                for (int bj = 0; bj < 2; ++bj) {
                    const f32x4 v0 = acc[ai][bj][m][0], v1 = acc[ai][bj][m][1];
                    s += (v0[0] * v0[0] + v0[1] * v0[1]) + (v0[2] * v0[2] + v0[3] * v0[3]) + (v1[0] * v1[0] + v1[1] * v1[1]) + (v1[2] * v1[2] + v1[3] * v1[3]);
                    u32x4 w; w.x = cvt_pk_bf16(v0[0], v0[1]); w.y = cvt_pk_bf16(v0[2], v0[3]); w.z = cvt_pk_bf16(v1[0], v1[1]); w.w = cvt_pk_bf16(v1[2], v1[3]);
                    *(u32x4*)(Y + (size_t)row * ldc + colb + bj * HALF) = w;
                }
                s += __shfl_xor(s, 16); s += __shfl_xor(s, 32);
                if (fq == 0) part[(size_t)row * 16 + u.pn * 4 + wc] = s;
            }
    }
};

template <class Epi, bool ALIGN_EPI = true>
__device__ __forceinline__ void gemm_phase(LAS unsigned char* lds, const Gemm g, const StaticOrder& S, const Epi& E) {
    int tid_ = threadIdx.x; asm volatile("" : "+v"(tid_));
    const int tid = tid_, wid = __builtin_amdgcn_readfirstlane(tid >> 6), lane = tid & 63, wr = wid >> 2, wc = wid & 3, fr = lane & 15, fq = lane >> 4;
    const int K = g.K, nt = K / BK;
    unsigned voffA[2], voffB[2];
#pragma unroll
    for (int i = 0; i < 2; ++i) { int R, C; stage_rc(tid * 16 + i * 8192, R, C); const int Rb = Epi::PERM ? ((R & ~31) + perm32(R & 31)) : R;
        voffA[i] = (unsigned)(R * g.lda + C) * 2u; voffB[i] = (unsigned)(Rb * g.ldb + C) * 2u; }
    const size_t kstep = (size_t)(BK * 2);
    const size_t hstepA = (size_t)HALF * g.lda * 2, hstepB = (size_t)HALF * g.ldb * 2;
    const size_t tstepA = 2 * hstepA, tstepB = 2 * hstepB;
    const unsigned ldsw = (unsigned)wid * 1024u;
    const int aoff = lds_byte(wr * 64 + fr, fq * 8), boff = lds_byte(wc * 32 + fr, fq * 8);
#define PG8_SA(b, h) (((b) * 2 + (h)) * HTB)
#define PG8_SB(b, h) ((4 + (b) * 2 + (h)) * HTB)
#define PG8_STAGE(bufoff, gbase, voff) do { _Pragma("unroll") for (int _i = 0; _i < 2; ++_i) \
        __builtin_amdgcn_global_load_lds((const unsigned*)((const char*)(gbase) + (voff)[_i]), (LAS unsigned*)(lds + (bufoff) + ldsw + _i * 8192), 16, 0, 0); } while (0)
#define PG8_LDA(dst, b, h) do { _Pragma("unroll") for (int m = 0; m < 4; ++m) _Pragma("unroll") for (int k = 0; k < 2; ++k) dst[m][k] = *(const LAS bf16x8*)(lds + PG8_SA(b, h) + aoff + m * 2048 + k * 1024); } while (0)
#define PG8_LDB(dst, b, h) do { _Pragma("unroll") for (int n = 0; n < 2; ++n) _Pragma("unroll") for (int k = 0; k < 2; ++k) dst[n][k] = *(const LAS bf16x8*)(lds + PG8_SB(b, h) + boff + n * 2048 + k * 1024); } while (0)
#define PG8_MMA(ai, bj, At, Bt) do { __builtin_amdgcn_s_setprio(1); _Pragma("unroll") for (int m = 0; m < 4; ++m) _Pragma("unroll") for (int n = 0; n < 2; ++n) _Pragma("unroll") for (int k = 0; k < 2; ++k) \
        acc[ai][bj][m][n] = __builtin_amdgcn_mfma_f32_16x16x32_bf16(Bt[n][k], At[m][k], acc[ai][bj][m][n], 0, 0, 0); __builtin_amdgcn_s_setprio(0); } while (0)
#define PG8_WAIT_V(n) asm volatile("s_waitcnt vmcnt(" #n ")" ::: "memory")
#define PG8_WAIT_L(n) asm volatile("s_waitcnt lgkmcnt(" #n ")" ::: "memory")
#define PG8_BAR __builtin_amdgcn_s_barrier()
#define PG8_SCHED __builtin_amdgcn_sched_barrier(0)
    Unit cur, nxt; int ui = 0;
    if (!S.next(0, cur)) return;
    f32x4 acc[2][2][4][2];
#pragma unroll
    for (int a = 0; a < 2; ++a)
#pragma unroll
        for (int b = 0; b < 2; ++b)
#pragma unroll
            for (int m = 0; m < 4; ++m)
#pragma unroll
                for (int n = 0; n < 2; ++n) acc[a][b][m][n] = (f32x4){0.f, 0.f, 0.f, 0.f};
    bf16x8 At[4][2], B0[2][2], B1[2][2];
    const char* cA = (const char*)g.A + (size_t)cur.pm * tstepA; const char* cB = (const char*)g.Bt + (size_t)cur.pn * tstepB;
    PG8_STAGE(PG8_SB(0, 0), cB, voffB); PG8_STAGE(PG8_SB(0, 1), cB + hstepB, voffB); PG8_STAGE(PG8_SA(0, 0), cA, voffA); PG8_STAGE(PG8_SA(0, 1), cA + hstepA, voffA);
    if (wr == 1) PG8_BAR;
    PG8_WAIT_V(2); PG8_BAR;
    PG8_STAGE(PG8_SB(1, 0), cB + kstep, voffB); PG8_STAGE(PG8_SA(1, 0), cA + kstep, voffA); PG8_STAGE(PG8_SB(1, 1), cB + hstepB + kstep, voffB);
    PG8_WAIT_V(6); PG8_BAR;
    for (;;) {
        const bool has_next = S.next(ui + 1, nxt);
        const char* nA = has_next ? (const char*)g.A + (size_t)nxt.pm * tstepA : cA; const char* nB = has_next ? (const char*)g.Bt + (size_t)nxt.pn * tstepB : cB;
#pragma unroll 1
        for (int t = 0; t < nt; t += 2) {
            const bool last = (t == nt - 2);
            const char* a1 = cA + (size_t)(t + 1) * kstep;
            const char* a2 = last ? nA : cA + (size_t)(t + 2) * kstep; const char* b2 = last ? nB : cB + (size_t)(t + 2) * kstep;
            const char* a3 = a2 + kstep; const char* b3 = b2 + kstep;
            PG8_LDB(B0, 0, 0); PG8_LDB(B1, 0, 1); PG8_SCHED; PG8_LDA(At, 0, 0); PG8_STAGE(PG8_SA(1, 1), a1 + hstepA, voffA);
            PG8_WAIT_V(8); PG8_WAIT_L(0); PG8_BAR; PG8_MMA(0, 0, At, B0); PG8_MMA(0, 1, At, B1); PG8_BAR; PG8_SCHED;
            PG8_LDA(At, 0, 1); PG8_STAGE(PG8_SB(0, 0), b2, voffB); PG8_STAGE(PG8_SB(0, 1), b2 + hstepB, voffB); PG8_STAGE(PG8_SA(0, 0), a2, voffA);
            PG8_WAIT_V(8); PG8_WAIT_L(0); PG8_BAR; PG8_MMA(1, 0, At, B0); PG8_MMA(1, 1, At, B1); PG8_BAR; PG8_SCHED;
            PG8_LDB(B0, 1, 0); PG8_LDB(B1, 1, 1); PG8_SCHED; PG8_LDA(At, 1, 0); PG8_STAGE(PG8_SA(0, 1), a2 + hstepA, voffA);
            PG8_WAIT_V(8); PG8_WAIT_L(0); PG8_BAR; PG8_MMA(0, 0, At, B0); PG8_MMA(0, 1, At, B1); PG8_BAR; PG8_SCHED;
            PG8_LDA(At, 1, 1); PG8_STAGE(PG8_SB(1, 0), b3, voffB); PG8_STAGE(PG8_SB(1, 1), b3 + hstepB, voffB); PG8_STAGE(PG8_SA(1, 0), a3, voffA);
            PG8_WAIT_V(8); PG8_WAIT_L(0); PG8_BAR; PG8_MMA(1, 0, At, B0); PG8_MMA(1, 1, At, B1); PG8_BAR; PG8_SCHED;
        }
        if constexpr (ALIGN_EPI) { if (wr == 0) PG8_BAR; }
        E(acc, cur, wr, wc, fr, fq);
        if (!has_next) break;
#pragma unroll
        for (int a = 0; a < 2; ++a)
#pragma unroll
            for (int b = 0; b < 2; ++b)
#pragma unroll
                for (int m = 0; m < 4; ++m)
#pragma unroll
                    for (int n = 0; n < 2; ++n) acc[a][b][m][n] = (f32x4){0.f, 0.f, 0.f, 0.f};
        cur = nxt; cA = nA; cB = nB; ++ui;
        if constexpr (ALIGN_EPI) { if (wr == 1) PG8_BAR; }
    }
    PG8_WAIT_V(0);
    if constexpr (!ALIGN_EPI) { if (wr == 0) PG8_BAR; }
    PG8_BAR;
#undef PG8_SA
#undef PG8_SB
#undef PG8_STAGE
#undef PG8_LDA
#undef PG8_LDB
#undef PG8_MMA
#undef PG8_WAIT_V
#undef PG8_WAIT_L
#undef PG8_BAR
#undef PG8_SCHED
}
}

__device__ __forceinline__ int win_src_col(int n) {
    if (n < 1024) { const int m = n & 63; if (m < 16) { const int i = m >> 1; return (n & ~63) + ((m & 1) ? i + 8 : i); } return n; }
    if (n >= 1536 && n < 2560) { const int m = n & 63, i = m >> 1; return (n & ~63) + ((m & 1) ? i + 32 : i); }
    return n;
}
template <bool MAP> __device__ __forceinline__ void transpose_item(const float* W, int K, int N, const float* gain, bf16_t* WT, LAS float* scr, int item, int lane) {
    const int nblk = N / 32, kb = item / nblk, nb = item % nblk, k0 = 64 * kb, n0 = 32 * nb;
    const int nd = n0 + (lane & 31); const int ns = MAP ? win_src_col(nd) : nd;
#pragma unroll 8
    for (int i = 0; i < 32; ++i) { const int kk = 2 * i + (lane >> 5); float v = W[(size_t)(k0 + kk) * N + ns]; if (gain) v *= gain[k0 + kk]; scr[kk * 33 + (lane & 31)] = v; }
    asm volatile("s_waitcnt lgkmcnt(0)" ::: "memory");
    const int c = lane & 7;
#pragma unroll
    for (int j = 0; j < 4; ++j) { const int n = (lane >> 3) + 8 * j; const LAS float* s = scr + (8 * c) * 33 + n;
        u32x4 o; o.x = cvt_pk_bf16(s[0 * 33], s[1 * 33]); o.y = cvt_pk_bf16(s[2 * 33], s[3 * 33]); o.z = cvt_pk_bf16(s[4 * 33], s[5 * 33]); o.w = cvt_pk_bf16(s[6 * 33], s[7 * 33]);
        *(u32x4*)(WT + (size_t)(n0 + n) * K + k0 + 8 * c) = o; }
    asm volatile("s_waitcnt lgkmcnt(0)" ::: "memory");
}

struct Args { const float* in[16]; float* out; unsigned char* ws; };
typedef const __attribute__((address_space(4))) Args* KArgs;
#define KA() ({ KArgs p_ = (KArgs)__builtin_amdgcn_kernarg_segment_ptr(); asm volatile("" : "+s"(p_)); p_; })
#define WSP(off) (KA()->ws + (off))

__device__ __forceinline__ void convert_layer(KArgs a, int layer, LAS unsigned char* lds, int tid, int wid, int lane) {
    LAS float* scr = (LAS float*)(lds + wid * 8448);
    bf16_t* WB = (bf16_t*)(a->ws + WS_WB);
    const int gw = blockIdx.x * 8 + wid, NGW = gridDim.x * 8;
    constexpr int I_IN = 16 * 208, I_AO = 8 * 32, I_RO = 16 * 32, I_WO = 16 * 32, I_UP = 16 * 128, I_DN = 64 * 32, I_PG = 16 * 32, I_PP = 4 * 32;
    constexpr int NITEMS = I_IN + I_AO + I_RO + I_WO + I_UP + I_DN + I_PG + I_PP;
    for (int it = gw; it < NITEMS; it += NGW) {
        int r = it;
        if (r < I_IN) { transpose_item<true>(a->in[2] + (size_t)layer * 1024 * 6656, 1024, 6656, a->in[11] + layer * 1024, WB + WB_IN, scr, r, lane); continue; } r -= I_IN;
        if (r < I_AO) { transpose_item<false>(a->in[3] + (size_t)layer * 512 * 1024, 512, 1024, nullptr, WB + WB_AO, scr, r, lane); continue; } r -= I_AO;
        if (r < I_RO) { transpose_item<false>(a->in[4] + (size_t)layer * 1024 * 1024, 1024, 1024, nullptr, WB + WB_RO, scr, r, lane); continue; } r -= I_RO;
        if (r < I_WO) { transpose_item<false>(a->in[5] + (size_t)layer * 1024 * 1024, 1024, 1024, nullptr, WB + WB_WO, scr, r, lane); continue; } r -= I_WO;
        if (r < I_UP) { transpose_item<false>(a->in[6] + (size_t)layer * 1024 * 4096, 1024, 4096, a->in[13] + layer * 1024, WB + WB_UP, scr, r, lane); continue; } r -= I_UP;
        if (r < I_DN) { transpose_item<false>(a->in[7] + (size_t)layer * 4096 * 1024, 4096, 1024, nullptr, WB + WB_DN, scr, r, lane); continue; } r -= I_DN;
        if (r < I_PG) { transpose_item<false>(a->in[8] + (size_t)layer * 1024 * 1024, 1024, 1024, nullptr, WB + WB_PG, scr, r, lane); continue; } r -= I_PG;
        transpose_item<false>(a->in[9] + (size_t)layer * 256 * 1024, 256, 1024, nullptr, WB + WB_PP, scr, r, lane);
    }
    const f32x4* ps = (const f32x4*)(a->in[1] + (size_t)layer * M * PLE); u32x4* pd = (u32x4*)(a->ws + WS_PB);
    const int gt = blockIdx.x * 512 + tid, NT = gridDim.x * 512;
    for (int i = gt; i < M * PLE / 8; i += NT) { const f32x4 x0 = ps[2 * i], x1 = ps[2 * i + 1];
        u32x4 w; w.x = cvt_pk_bf16(x0[0], x0[1]); w.y = cvt_pk_bf16(x0[2], x0[3]); w.z = cvt_pk_bf16(x1[0], x1[1]); w.w = cvt_pk_bf16(x1[2], x1[3]); pd[i] = w; }
}

__device__ __forceinline__ void sincos_acc(float xf, float& c, float& s) {
    const double x = (double)xf; const double k = rint(x * 0.15915494309189535);
    double r = fma(-k, 6.283185307179586, x); r = fma(-k, 2.4492935982947064e-16, r);
    const double r2 = r * r;
    double sp = 1.0, cp = 1.0;
#pragma unroll
    for (int i = 13; i >= 1; --i) { sp = 1.0 - sp * r2 / (double)((2 * i) * (2 * i + 1)); cp = 1.0 - cp * r2 / (double)((2 * i - 1) * (2 * i)); }
    s = (float)(r * sp); c = (float)cp;
}
__device__ __forceinline__ void build_tables(KArgs a) {
    f32x2* tabA = (f32x2*)(a->ws + WS_TABA); f32x2* tabR = (f32x2*)(a->ws + WS_TABR);
    const int gt = blockIdx.x * 512 + threadIdx.x, NT = gridDim.x * 512;
    for (int e = gt; e < 4096 * 40; e += NT) {
        const int pos = e / 40, j = e % 40; float inv;
        if (j < 8) inv = (float)exp2(-(double)j * 0.125 * 18.931568569324174);
        else inv = (float)exp2(-(double)(j - 8) * 0.03125 * 13.287712379549449);
        const float ang = (float)pos * inv; float c, s; sincos_acc(ang, c, s);
        if (j < 8) tabA[pos * 8 + j] = (f32x2){c, s}; else tabR[pos * 32 + (j - 8)] = (f32x2){c, s};
    }
}

__device__ __forceinline__ void row_pass(const float* x0, float* fout, const bf16_t* Y, int ldy, const float* part, const float* gain, const bf16_t* G, int ldg,
                                         bf16_t* hb, float* rs, int wid, int lane) {
    const int gw = blockIdx.x * 8 + wid, NGW = gridDim.x * 8;
    for (int row = gw; row < M; row += NGW) {
        float rsy = 0.f;
        if (Y) { float pz = (lane < 16) ? part[(size_t)row * 16 + lane] : 0.f; pz = wave_sum(pz); rsy = 1.0f / sqrtf(pz * (1.0f / D) + NORM_EPS); }
        float ss = 0.f;
#pragma unroll
        for (int j = 0; j < 4; ++j) {
            const int col = 4 * lane + 256 * j;
            f32x4 h;
            if (x0) h = *(const f32x4*)(x0 + (size_t)row * D + col);
            else { const u32x2 hw = *(const u32x2*)(hb + (size_t)row * D + col); h = (f32x4){bflo(hw.x), bfhi(hw.x), bflo(hw.y), bfhi(hw.y)}; }
            if (Y) {
                const u32x2 yw = *(const u32x2*)(Y + (size_t)row * ldy + col); const f32x4 gn = *(const f32x4*)(gain + col);
                f32x4 y = (f32x4){bflo(yw.x), bfhi(yw.x), bflo(yw.y), bfhi(yw.y)};
                y = y * rsy * gn;
                if (G) { const u32x2 gw2 = *(const u32x2*)(G + (size_t)row * ldg + col); y = y * (f32x4){bflo(gw2.x), bfhi(gw2.x), bflo(gw2.y), bfhi(gw2.y)}; }
                h = h + y;
            }
            if (fout) *(f32x4*)(fout + (size_t)row * D + col) = h;
            u32x2 o; o.x = cvt_pk_bf16(h[0], h[1]); o.y = cvt_pk_bf16(h[2], h[3]); *(u32x2*)(hb + (size_t)row * D + col) = o;
            ss += (h[0] * h[0] + h[1] * h[1]) + (h[2] * h[2] + h[3] * h[3]);
        }
        ss = wave_sum(ss);
        if (lane == 0) rs[row] = 1.0f / sqrtf(ss * (1.0f / D) + NORM_EPS);
    }
}

constexpr int AT_ORS = 272, AT_ML = 69632, AT_V = 71680;
__device__ __forceinline__ void att_load(int kbase, int sh, int rho, int L, const bf16_t* Pb, int lane, bf16x8 (&kn)[2][2], u32x4 (&vn)[4]) {
    const int n = lane & 15, g = lane >> 4;
#pragma unroll
    for (int t = 0; t < 2; ++t) { int ik = kbase + 16 * t + n; ik = ik < 0 ? 0 : (ik >= L ? L - 1 : ik); const bf16_t* kp = Pb + (unsigned)((rho + (ik << sh)) * LDP + C_KA);
        kn[t][0] = *(const bf16x8*)(kp + 8 * g); kn[t][1] = *(const bf16x8*)(kp + 32 + 8 * g); }
#pragma unroll
    for (int x = 0; x < 4; ++x) { int ik = kbase + (lane >> 3) + 8 * x; ik = ik < 0 ? 0 : (ik >= L ? L - 1 : ik);
        vn[x] = *(const u32x4*)(Pb + (unsigned)((rho + (ik << sh)) * LDP + C_VA + (lane & 7) * 8)); }
}
__device__ __forceinline__ void att_step(bool fast, int kbase, int L, int iqn, int lane, LAS unsigned char* vbuf, unsigned troff, const bf16x8 (&kc)[2][2], const u32x4 (&vc)[4],
                                         bf16x8 qf0, bf16x8 qf1, float& mrun, float& lrun, f32x4 (&ot)[4]) {
    const int g = lane >> 4;
#pragma unroll
    for (int x = 0; x < 4; ++x) *(LAS u32x4*)(vbuf + ((lane >> 3) + 8 * x) * 144 + (lane & 7) * 16) = vc[x];
    f32x4 s0 = (f32x4){0.f, 0.f, 0.f, 0.f}, s1 = (f32x4){0.f, 0.f, 0.f, 0.f};
    s0 = __builtin_amdgcn_mfma_f32_16x16x32_bf16(kc[0][0], qf0, s0, 0, 0, 0); s0 = __builtin_amdgcn_mfma_f32_16x16x32_bf16(kc[0][1], qf1, s0, 0, 0, 0);
    s1 = __builtin_amdgcn_mfma_f32_16x16x32_bf16(kc[1][0], qf0, s1, 0, 0, 0); s1 = __builtin_amdgcn_mfma_f32_16x16x32_bf16(kc[1][1], qf1, s1, 0, 0, 0);
    if (!fast) {
#pragma unroll
        for (int i = 0; i < 4; ++i) {
            const int ik0 = kbase + 4 * g + i, ik1 = ik0 + 16;
            const bool ok0 = ((unsigned)ik0 < (unsigned)L) && ((unsigned)(iqn - ik0 + 64) <= 128u), ok1 = ((unsigned)ik1 < (unsigned)L) && ((unsigned)(iqn - ik1 + 64) <= 128u);
            s0[i] = ok0 ? s0[i] : -1e30f; s1[i] = ok1 ? s1[i] : -1e30f;
        }
    }
    float tmax = fmaxf(fmaxf(fmaxf(s0[0], s0[1]), fmaxf(s0[2], s0[3])), fmaxf(fmaxf(s1[0], s1[1]), fmaxf(s1[2], s1[3])));
    tmax = fmaxf(tmax, __shfl_xor(tmax, 16)); tmax = fmaxf(tmax, __shfl_xor(tmax, 32));
    const float mnew = fmaxf(mrun, tmax), alpha = __builtin_amdgcn_exp2f(mrun - mnew);
    f32x4 p0, p1; float ps = 0.f;
#pragma unroll
    for (int i = 0; i < 4; ++i) {
        p0[i] = __builtin_amdgcn_exp2f(s0[i] - mnew); p1[i] = __builtin_amdgcn_exp2f(s1[i] - mnew); ps += p0[i] + p1[i]; }
    lrun = lrun * alpha + ps; mrun = mnew;
#pragma unroll
    for (int t = 0; t < 4; ++t) ot[t] = ot[t] * alpha;
    const bf16x8 pf = pack8(p0, p1);
    asm volatile("" ::: "memory");
#pragma unroll
    for (int t = 0; t < 4; ++t) {
        const s16x4 lo = tr_read(vbuf + troff + t * 32), hi = tr_read(vbuf + troff + 16 * 144 + t * 32);
        ot[t] = __builtin_amdgcn_mfma_f32_16x16x32_bf16(cat8(lo, hi), pf, ot[t], 0, 0, 0);
    }
    asm volatile("" ::: "memory");
}
__device__ __forceinline__ void attn_phase(LAS unsigned char* lds, bf16_t* P, bf16_t* Od, int ldo, int wid, int lane) {
    const int n = lane & 15, g = lane >> 4;
    LAS unsigned char* vb = lds + AT_V + wid * 9216;
    const unsigned troff = (unsigned)((4 * g + ((lane & 15) >> 2)) * 144 + (lane & 3) * 8);
    for (int unit = blockIdx.x; unit < 1024; unit += gridDim.x) {
        const int blk = unit & 15, bh = unit >> 4, h = bh & 7, b = bh >> 3;
        const bf16_t* Pb = P + (size_t)b * SEQ * LDP + h * 64;
#pragma unroll 1
        for (int grp = 0; grp < 3; ++grp) {
#pragma unroll 1
            for (int jj = 0; jj < 2; ++jj) {
                const int j = wid + 8 * jj;
                int sh, rho, iq0;
                if (grp == 0) { sh = 0; rho = 0; iq0 = blk * 256 + 16 * j; }
                else if (grp == 1) { sh = 2; rho = j & 3; iq0 = blk * 64 + 16 * (j >> 2); }
                else { sh = 4; rho = j; iq0 = blk * 16; }
                const int L = SEQ >> sh, iqn = iq0 + n, kb0 = iq0 - 64;
                const int tq = rho + (iqn << sh), tloc = tq - blk * 256;
                const bf16_t* Pq = Pb + (unsigned)(tq * LDP);
                const bf16x8 qf0 = *(const bf16x8*)(Pq + C_QA + 8 * g), qf1 = *(const bf16x8*)(Pq + C_QA + 32 + 8 * g);
                bf16x8 kA[2][2], kB[2][2]; u32x4 vA[4], vB[4];
                att_load(kb0, sh, rho, L, Pb, lane, kA, vA); att_load(kb0 + 32, sh, rho, L, Pb, lane, kB, vB);
                float mrun = -1e4f, lrun = 0.f; f32x4 ot[4];
#pragma unroll
                for (int t = 0; t < 4; ++t) ot[t] = (f32x4){0.f, 0.f, 0.f, 0.f};
                const bool inr = (kb0 + 32 >= 0) && (kb0 + 128 <= L);
                att_step(false, kb0, L, iqn, lane, vb, troff, kA, vA, qf0, qf1, mrun, lrun, ot);
                att_load(kb0 + 64, sh, rho, L, Pb, lane, kA, vA);
                att_step(inr, kb0 + 32, L, iqn, lane, vb + 4608, troff, kB, vB, qf0, qf1, mrun, lrun, ot);
                att_load(kb0 + 96, sh, rho, L, Pb, lane, kB, vB);
                att_step(inr, kb0 + 64, L, iqn, lane, vb, troff, kA, vA, qf0, qf1, mrun, lrun, ot);
                att_load(kb0 + 128, sh, rho, L, Pb, lane, kA, vA);
                att_step(inr, kb0 + 96, L, iqn, lane, vb + 4608, troff, kB, vB, qf0, qf1, mrun, lrun, ot);
                att_step(false, kb0 + 128, L, iqn, lane, vb, troff, kA, vA, qf0, qf1, mrun, lrun, ot);
                float l = lrun; l += __shfl_xor(l, 16); l += __shfl_xor(l, 32);
                LAS unsigned char* orow = lds + tloc * AT_ORS + 16 * g;
                LAS f32x2* ml = (LAS f32x2*)(lds + AT_ML) + tloc;
                if (grp == 0) {
#pragma unroll
                    for (int t = 0; t < 4; ++t) *(LAS f32x4*)(orow + 64 * t) = ot[t];
                    if (g == 0) *ml = (f32x2){mrun, l};
                } else {
                    const f32x2 o_ml = *ml; const float mn = fmaxf(o_ml[0], mrun), ao = __builtin_amdgcn_exp2f(o_ml[0] - mn), ac = __builtin_amdgcn_exp2f(mrun - mn);
                    const float ln = o_ml[1] * ao + l * ac;
                    if (grp == 1) {
#pragma unroll
                        for (int t = 0; t < 4; ++t) { const f32x4 oo = *(LAS f32x4*)(orow + 64 * t); *(LAS f32x4*)(orow + 64 * t) = oo * ao + ot[t] * ac; }
                        asm volatile("s_waitcnt lgkmcnt(0)" ::: "memory");
                        if (g == 0) *ml = (f32x2){mn, ln};
                    } else {
                        const float inv = 1.0f / ln;
#pragma unroll
                        for (int t = 0; t < 4; ++t) { const f32x4 oo = *(LAS f32x4*)(orow + 64 * t); const f32x4 r = (oo * ao + ot[t] * ac) * inv;
                            u32x2 o; o.x = cvt_pk_bf16(r[0], r[1]); o.y = cvt_pk_bf16(r[2], r[3]);
                            *(u32x2*)(Od + ((size_t)b * SEQ + tq) * ldo + h * 64 + 16 * t + 4 * g) = o; }
                    }
                }
            }
            __syncthreads();
        }
    }
}

__device__ __forceinline__ void ret_kv_phase(LAS unsigned char* lds, const bf16_t* P, bf16_t* KV, const float* dl, int tid, int wid, int lane) {
    constexpr int KF = 0, KB = 18432, VO = 36864;
    const int g = lane >> 4, li = lane & 15, trq = li >> 2, trp = li & 3;
    for (int unit = blockIdx.x; unit < 2048; unit += gridDim.x) {
        const int bh = unit >> 5, nn = unit & 31, b = bh >> 3, h = bh & 7;
        const float lgf = logsig(dl[h]), lgb = logsig(dl[8 + h]);
        const size_t row0 = (size_t)b * SEQ + nn * 128;
#pragma unroll
        for (int x = 0; x < 2; ++x) { const int q = tid + 512 * x, R = q >> 3, pc = q & 7;
            const u32x4 w = *(const u32x4*)(P + (row0 + R) * LDP + C_KR + h * 64 + pc * 8);
            const float zf = __builtin_amdgcn_exp2f(lgf * 1.4426950408889634f * (float)(127 - R)), zb = __builtin_amdgcn_exp2f(lgb * 1.4426950408889634f * (float)R);
            *(LAS u32x4*)(lds + KF + R * 144 + pc * 16) = scale8(w, zf); *(LAS u32x4*)(lds + KB + R * 144 + pc * 16) = scale8(w, zb); }
#pragma unroll
        for (int x = 0; x < 4; ++x) { const int q = tid + 512 * x, R = q >> 4, pc = q & 15;
            *(LAS u32x4*)(lds + VO + R * 272 + pc * 16) = *(const u32x4*)(P + (row0 + R) * LDP + C_VR + h * 128 + pc * 8); }
        __syncthreads();
        f32x4 acc[8];
#pragma unroll
        for (int i = 0; i < 8; ++i) acc[i] = (f32x4){0.f, 0.f, 0.f, 0.f};
#pragma unroll
        for (int ks = 0; ks < 4; ++ks) {
            const int tr0 = 32 * ks + 8 * g + trq;
            const bf16x8 af = cat8(tr_read(lds + VO + tr0 * 272 + (16 * wid + 4 * trp) * 2), tr_read(lds + VO + (tr0 + 4) * 272 + (16 * wid + 4 * trp) * 2));
#pragma unroll
            for (int dkt = 0; dkt < 8; ++dkt) {
                const int ko = (dkt < 4 ? KF : KB) + (16 * (dkt & 3) + 4 * trp) * 2;
                const bf16x8 bf = cat8(tr_read(lds + ko + tr0 * 144), tr_read(lds + ko + (tr0 + 4) * 144));
                acc[dkt] = __builtin_amdgcn_mfma_f32_16x16x32_bf16(af, bf, acc[dkt], 0, 0, 0);
            }
        }
        bf16_t* KVu = KV + (size_t)unit * 16384;
#pragma unroll
        for (int dkt = 0; dkt < 8; ++dkt) { u32x2 o; o.x = cvt_pk_bf16(acc[dkt][0], acc[dkt][1]); o.y = cvt_pk_bf16(acc[dkt][2], acc[dkt][3]);
            *(u32x2*)(KVu + (dkt >> 2) * 8192 + (16 * (dkt & 3) + li) * 128 + 16 * wid + 4 * g) = o; }
        __syncthreads();
    }
}
__device__ __forceinline__ void ret_scan_phase(bf16_t* KV, const float* dl, int tid) {
    const int gt = blockIdx.x * 512 + tid, NT = gridDim.x * 512;
    for (int e = gt; e < 64 * 8192; e += NT) {
        const int bh = e >> 13, pp = e & 8191, dir = pp >> 12, h = bh & 7;
        const float G = expf(128.0f * logsig(dl[dir * 8 + h]));
        unsigned* base = (unsigned*)KV + (size_t)bh * 32 * 8192 + pp;
        unsigned w[32];
#pragma unroll
        for (int st = 0; st < 32; ++st) w[st] = base[(size_t)st * 8192];
        float s0 = 0.f, s1 = 0.f;
        if (dir == 0) {
#pragma unroll
            for (int st = 0; st < 32; ++st) { const unsigned o = cvt_pk_bf16(s0, s1); s0 = s0 * G + bflo(w[st]); s1 = s1 * G + bfhi(w[st]); w[st] = o; }
        } else {
#pragma unroll
            for (int st = 31; st >= 0; --st) { const unsigned o = cvt_pk_bf16(s0, s1); s0 = s0 * G + bflo(w[st]); s1 = s1 * G + bfhi(w[st]); w[st] = o; }
        }
#pragma unroll
        for (int st = 0; st < 32; ++st) base[(size_t)st * 8192] = w[st];
    }
}
__device__ __forceinline__ void ret_out_phase(LAS unsigned char* lds, bf16_t* P, int ocol, const bf16_t* KV, const float* dl, int tid, int wid, int lane) {
    constexpr int KO = 0, VO = 18432, SF = 53248, SB = 70656;
    const int g = lane >> 4, li = lane & 15, trq = li >> 2, trp = li & 3;
    for (int unit = blockIdx.x; unit < 2048; unit += gridDim.x) {
        const int bh = unit >> 5, nn = unit & 31, b = bh >> 3, h = bh & 7;
        const float lgf = logsig(dl[h]), lgb = logsig(dl[8 + h]);
        const size_t row0 = (size_t)b * SEQ + nn * 128;
        const bf16_t* KVu = KV + (size_t)unit * 16384;
#pragma unroll
        for (int x = 0; x < 2; ++x) { const int q = tid + 512 * x, R = q >> 3, pc = q & 7;
            *(LAS u32x4*)(lds + KO + R * 144 + pc * 16) = *(const u32x4*)(P + (row0 + R) * LDP + C_KR + h * 64 + pc * 8); }
#pragma unroll
        for (int x = 0; x < 4; ++x) { const int q = tid + 512 * x, R = q >> 4, pc = q & 15;
            *(LAS u32x4*)(lds + VO + R * 272 + pc * 16) = *(const u32x4*)(P + (row0 + R) * LDP + C_VR + h * 128 + pc * 8); }
#pragma unroll
        for (int x = 0; x < 4; ++x) { const int q = tid + 512 * x, dir = q >> 10, R = (q >> 4) & 63, pc = q & 15;
            *(LAS u32x4*)(lds + (dir ? SB : SF) + R * 272 + pc * 16) = *(const u32x4*)(KVu + dir * 8192 + R * 128 + pc * 8); }
        const int a = 16 * wid + li;
        bf16_t* Pr = P + (row0 + a) * LDP;
        const u32x4 q0 = *(const u32x4*)(Pr + C_QR + h * 64 + 8 * g), q1 = *(const u32x4*)(Pr + C_QR + h * 64 + 32 + 8 * g);
        const float lgf2 = lgf * 1.4426950408889634f, lgb2 = lgb * 1.4426950408889634f;
        const float xf = __builtin_amdgcn_exp2f(lgf2 * (float)(a + 1)), xb = __builtin_amdgcn_exp2f(lgb2 * (float)(128 - a));
        const bf16x8 qr0 = __builtin_bit_cast(bf16x8, q0), qr1 = __builtin_bit_cast(bf16x8, q1);
        const bf16x8 qf0 = __builtin_bit_cast(bf16x8, scale8(q0, xf)), qf1 = __builtin_bit_cast(bf16x8, scale8(q1, xf));
        const bf16x8 qb0 = __builtin_bit_cast(bf16x8, scale8(q0, xb)), qb1 = __builtin_bit_cast(bf16x8, scale8(q1, xb));
        __syncthreads();
        bf16x8 pf[4];
#pragma unroll
        for (int kp = 0; kp < 4; ++kp) {
            f32x4 st[2];
#pragma unroll
            for (int t = 0; t < 2; ++t) {
                const int kt = 2 * kp + t;
                const bf16x8 k0 = *(const LAS bf16x8*)(lds + KO + (16 * kt + li) * 144 + 16 * g), k1 = *(const LAS bf16x8*)(lds + KO + (16 * kt + li) * 144 + 64 + 16 * g);
                f32x4 s = (f32x4){0.f, 0.f, 0.f, 0.f};
                s = __builtin_amdgcn_mfma_f32_16x16x32_bf16(k0, qr0, s, 0, 0, 0); s = __builtin_amdgcn_mfma_f32_16x16x32_bf16(k1, qr1, s, 0, 0, 0);
#pragma unroll
                for (int i = 0; i < 4; ++i) { const int key = 16 * kt + 4 * g + i, d = a - key; const float w = __builtin_amdgcn_exp2f(d >= 0 ? lgf2 * (float)d : lgb2 * (float)(-d)); s[i] *= w; }
                st[t] = s;
            }
            pf[kp] = pack8(st[0], st[1]);
        }
        f32x4 acc[8];
#pragma unroll
        for (int dt = 0; dt < 8; ++dt) {
            f32x4 c = (f32x4){0.f, 0.f, 0.f, 0.f};
            const int co = (16 * dt + 4 * trp) * 2;
#pragma unroll
            for (int kp = 0; kp < 4; ++kp) {
                const bf16x8 vf = cat8(tr_read(lds + VO + (32 * kp + 4 * g + trq) * 272 + co), tr_read(lds + VO + (32 * kp + 16 + 4 * g + trq) * 272 + co));
                c = __builtin_amdgcn_mfma_f32_16x16x32_bf16(vf, pf[kp], c, 0, 0, 0);
            }
#pragma unroll
            for (int ks = 0; ks < 2; ++ks) {
                const int r0 = 32 * ks + 8 * g + trq;
                const bf16x8 sf = cat8(tr_read(lds + SF + r0 * 272 + co), tr_read(lds + SF + (r0 + 4) * 272 + co));
                c = __builtin_amdgcn_mfma_f32_16x16x32_bf16(sf, ks ? qf1 : qf0, c, 0, 0, 0);
                const bf16x8 sb = cat8(tr_read(lds + SB + r0 * 272 + co), tr_read(lds + SB + (r0 + 4) * 272 + co));
                c = __builtin_amdgcn_mfma_f32_16x16x32_bf16(sb, ks ? qb1 : qb0, c, 0, 0, 0);
            }
            acc[dt] = c;
        }
        float s = 0.f;
#pragma unroll
        for (int dt = 0; dt < 8; ++dt) s += (acc[dt][0] + acc[dt][1]) + (acc[dt][2] + acc[dt][3]);
        s += __shfl_xor(s, 16); s += __shfl_xor(s, 32);
        const float mu = s * (1.0f / 128.0f); float vq = 0.f;
#pragma unroll
        for (int dt = 0; dt < 8; ++dt) { const f32x4 d = acc[dt] - mu; vq += (d[0] * d[0] + d[1] * d[1]) + (d[2] * d[2] + d[3] * d[3]); }
        vq += __shfl_xor(vq, 16); vq += __shfl_xor(vq, 32);
        const float rstd = 1.0f / sqrtf(vq * (1.0f / 128.0f) + GN_EPS);
#pragma unroll
        for (int dt = 0; dt < 8; ++dt) {
            const int col = h * 128 + 16 * dt + 4 * g;
            const u32x2 gw = *(const u32x2*)(Pr + C_GR + col);
            const f32x4 y = (acc[dt] - mu) * rstd;
            u32x2 o; o.x = cvt_pk_bf16(y[0] * bflo(gw.x), y[1] * bfhi(gw.x)); o.y = cvt_pk_bf16(y[2] * bflo(gw.y), y[3] * bfhi(gw.y));
            *(u32x2*)(Pr + ocol + col) = o;
        }
        __syncthreads();
    }
}


#define XB_TMO      128
#define XB_XCNT(j)  (256  + 64 * (j))
#define XB_XSUB(j)  (1280 + 64 * (j))
#define XB_XGEN(j)  (2304 + 64 * (j))
#define XB_TOP      3328
#define XB_TOPGEN   3392
#define XCD_BAR_WORDS 3456
#define XB_SPIN_CAP (1u << 22)
__device__ __forceinline__ unsigned xb_ld(unsigned* p)              { return __hip_atomic_load(p, __ATOMIC_RELAXED, __HIP_MEMORY_SCOPE_AGENT); }
__device__ __forceinline__ unsigned xb_add(unsigned* p, unsigned v) { return __hip_atomic_fetch_add(p, v, __ATOMIC_RELAXED, __HIP_MEMORY_SCOPE_AGENT); }
__device__ __forceinline__ unsigned xb_xcc_id() { return (unsigned)__builtin_amdgcn_s_getreg((3 << 11) | 20) & 0xFu; }
#define XB_SPIN(cond, bar) do { unsigned _sp = 0; while (cond) { __builtin_amdgcn_s_sleep(1); \
    if ((++_sp & 255u) == 0u) { if (xb_ld(&(bar)[XB_TMO])) break; if (_sp > XB_SPIN_CAP) { atomicAdd(&(bar)[XB_TMO], 1u); break; } } } } while (0)
__device__ __forceinline__ void xcd_barrier_complete(unsigned* bar, unsigned x, unsigned& nloc, unsigned& nx) {
    const unsigned G = gridDim.x * gridDim.y * gridDim.z;
    unsigned sum, cnt, mine, sp = 0u;
    for (;;) {
        sum = 0u; cnt = 0u; mine = 0u;
#pragma unroll
        for (unsigned j = 0; j < 16; ++j) { const unsigned c = xb_ld(&bar[XB_XCNT(j)]); sum += c; cnt += (c > 0u) ? 1u : 0u; mine = (j == x) ? c : mine; }
        if (sum == G) break;
        __builtin_amdgcn_s_sleep(1);
        if ((++sp & 255u) == 0u) { if (xb_ld(&bar[XB_TMO])) break; if (sp > XB_SPIN_CAP) { atomicAdd(&bar[XB_TMO], 1u); break; } }
    }
    nloc = mine > 0u ? mine : 1u; nx = cnt > 0u ? cnt : 1u;
}
__device__ __forceinline__ void xcd_barrier(unsigned* bar, unsigned x, volatile LAS unsigned* st) {
    asm volatile("s_waitcnt vmcnt(0)" ::: "memory");
    __syncthreads();
    if (threadIdx.x == 0) {
        __builtin_amdgcn_s_waitcnt(0);
        unsigned nloc = st[0], nx = st[1];
        if (nloc == 0u) { xcd_barrier_complete(bar, x, nloc, nx); st[0] = nloc; st[1] = nx; }
        const unsigned old = xb_add(&bar[XB_XSUB(x)], 1u);
        const unsigned gen = old / nloc;
        if (old + 1u == (gen + 1u) * nloc) {
            __builtin_amdgcn_fence(__ATOMIC_RELEASE, "agent");
            asm volatile("s_waitcnt vmcnt(0)" ::: "memory");
            const unsigned og = xb_add(&bar[XB_TOP], 1u);
            const unsigned tg = og / nx;
            if (og + 1u == (tg + 1u) * nx) xb_add(&bar[XB_TOPGEN], 1u);
            else XB_SPIN(xb_ld(&bar[XB_TOPGEN]) == tg, bar);
            __builtin_amdgcn_fence(__ATOMIC_ACQUIRE, "agent");
            xb_add(&bar[XB_XGEN(x)], 1u);
            asm volatile("s_waitcnt vmcnt(0)" ::: "memory");
        } else {
            XB_SPIN(xb_ld(&bar[XB_XGEN(x)]) == gen, bar);
            __builtin_amdgcn_fence(__ATOMIC_ACQUIRE, "agent");
            asm volatile("s_waitcnt vmcnt(0)" ::: "memory");
        }
    }
    __syncthreads();
}

#ifndef DBG_STOP
#define DBG_STOP 0
#endif
__device__ __forceinline__ void dbg_dump(float* out, const bf16_t* s0, int ld0, int w0, const bf16_t* s1, int ld1, int w1) {
    const int gt = blockIdx.x * 512 + threadIdx.x, NT = gridDim.x * 512;
    for (int e = gt; e < M * D; e += NT) { const int row = e >> 10, c = e & 1023; float v = 0.f;
        for (int j = 0; c + 1024 * j < w0; ++j) v += bflo((unsigned)s0[(size_t)row * ld0 + c + 1024 * j]);
        if (s1) for (int j = 0; c + 1024 * j < w1; ++j) v += bflo((unsigned)s1[(size_t)row * ld1 + c + 1024 * j]);
        out[e] = v; }
}
#define DBG(k, s0, ld0, w0, s1, ld1, w1) do { if (DBG_STOP == (k) && layer == 0) { dbg_dump(hout, s0, ld0, w0, s1, ld1, w1); return; } } while (0)
#define DBGRET(k) do { if (DBG_STOP == (k) && layer == 0) return; } while (0)
#define GRID_SYNC() xcd_barrier((unsigned*)WSP(WS_CTL), xcc_id, (volatile LAS unsigned*)(lds + LDS_BYTES - 64))
__global__ void __launch_bounds__(512, 2) fwd_kernel(Args a) {
    extern __shared__ __attribute__((aligned(16))) unsigned char lds_raw[];
    LAS unsigned char* lds = (LAS unsigned char*)lds_raw;
    cg::grid_group grid = cg::this_grid();
    const unsigned xcc_id = xb_xcc_id();
    if (threadIdx.x < 16) ((LAS unsigned*)(lds + LDS_BYTES - 64))[threadIdx.x] = 0u;
    __syncthreads();
    if (threadIdx.x == 0) (void)xb_add((unsigned*)WSP(WS_CTL) + XB_XCNT(xcc_id), 1u);
    grid.sync();
    const int G = gridDim.x, cb = blockIdx.x;
#define WB ((bf16_t*)WSP(WS_WB))
#define tabA ((const f32x2*)WSP(WS_TABA))
#define tabR ((const f32x2*)WSP(WS_TABR))
#define rs ((float*)WSP(WS_RS))
#define part ((float*)WSP(WS_PART))
#define hb ((bf16_t*)WSP(WS_HB))
#define pb ((bf16_t*)WSP(WS_PB))
#define KV ((bf16_t*)WSP(WS_KV))
#define P ((bf16_t*)WSP(WS_PROJ))
#define hout (KA()->out)

#ifndef PHM
#define PHM 0xffff
#endif
#ifndef DUP
#define DUP 0
#endif
#define REP(bit) _Pragma("unroll 1") for (int rep_ = 0; rep_ < ((DUP & (bit)) ? 2 : 1); ++rep_)
    { const int tid = threadIdx.x, wid = __builtin_amdgcn_readfirstlane(tid >> 6), lane = tid & 63; (void)tid;
    if (PHM & 1) build_tables(KA());
    if (PHM & 2) convert_layer(KA(), 0, lds, tid, wid, lane);
    if (PHM & 4) row_pass(KA()->in[0], nullptr, nullptr, 0, nullptr, nullptr, nullptr, 0, hb, rs, wid, lane); }
    GRID_SYNC();

#pragma unroll 1
    for (int layer = 0; layer < DEPTH; ++layer) {
        const float* dl = KA()->in[10] + layer * 16;
        if (DUP & 512) { _Pragma("unroll 1") for (int xs = 0; xs < 20; ++xs) GRID_SYNC(); }
        int tid = threadIdx.x; asm volatile("" : "+v"(tid));
        const int wid = __builtin_amdgcn_readfirstlane(tid >> 6), lane = tid & 63;
        REP(1) if (PHM & 8) { pg8::Gemm g{hb, WB + WB_IN, M, 4608, 1024, 1024, 1024}; pg8::StaticOrder S; S.init(M, 4608, G, cb);
          pg8::EpiProj E{P, rs, tabA, tabR}; pg8::gemm_phase<pg8::EpiProj>(lds, g, S, E); }
        GRID_SYNC();
        DBG(1, P, LDP, 4608, nullptr, 0, 0);
        if (PHM & 16) attn_phase(lds, P, P, LDP, wid, lane);
        __syncthreads();
        REP(64) if (PHM & 32) ret_kv_phase(lds, P, KV, dl, tid, wid, lane);
        GRID_SYNC();
        DBG(2, P, LDP, 512, KV, 1024, 1024);
        if (PHM & 64) ret_scan_phase(KV, dl, tid);
        GRID_SYNC();
        DBG(3, KV, 1024, 1024, nullptr, 0, 0);
        REP(256) if (PHM & 128) ret_out_phase(lds, P, ((DUP & 256) && rep_ == 0) ? C_S1 : C_VR, KV, dl, tid, wid, lane);
        GRID_SYNC();
        DBG(4, P + C_VR, LDP, 1024, nullptr, 0, 0);
        if (PHM & 256) { pg8::StaticOrder S; S.init(M, 1024, G, cb);
          REP(2) { pg8::Gemm g{hb, WB + WB_GA, M, 1024, 1024, 1024, 1024}; pg8::EpiAct<0> E{P + C_S1, LDP, rs}; pg8::gemm_phase<pg8::EpiAct<0>>(lds, g, S, E); }
          { pg8::Gemm g{P + C_QA, WB + WB_AO, M, 1024, 512, LDP, 512}; pg8::EpiMulAdd E{P + C_S1, nullptr, LDP}; pg8::gemm_phase<pg8::EpiMulAdd>(lds, g, S, E); }
          REP(2) { pg8::Gemm g{hb, WB + WB_GB, M, 1024, 1024, 1024, 1024}; pg8::EpiAct<0> E{P + C_S2, LDP, rs}; pg8::gemm_phase<pg8::EpiAct<0>>(lds, g, S, E); }
          { pg8::Gemm g{P + C_VR, WB + WB_RO, M, 1024, 1024, LDP, 1024}; pg8::EpiMulAdd E{P + C_S2, P + C_S1, LDP}; pg8::gemm_phase<pg8::EpiMulAdd>(lds, g, S, E); } }
        GRID_SYNC();
        DBG(5, P + C_S2, LDP, 1024, nullptr, 0, 0);
        REP(4) if (PHM & 512) { pg8::Gemm g{P + C_S2, WB + WB_WO, M, 1024, 1024, LDP, 1024}; pg8::StaticOrder S; S.init(M, 1024, G, cb);
          pg8::EpiY E{P + C_Y, LDP, part}; pg8::gemm_phase<pg8::EpiY>(lds, g, S, E); }
        GRID_SYNC();
        DBG(6, P + C_Y, LDP, 1024, nullptr, 0, 0);
        row_pass(nullptr, nullptr, P + C_Y, LDP, part, KA()->in[12] + layer * D, nullptr, 0, hb, rs, wid, lane);
        GRID_SYNC();
        DBGRET(7);
        REP(8) if (PHM & 1024) { pg8::Gemm g{hb, WB + WB_UP, M, FF, 1024, 1024, 1024}; pg8::StaticOrder S; S.init(M, FF, G, cb);
          pg8::EpiAct<1> E{P, FF, rs}; pg8::gemm_phase<pg8::EpiAct<1>>(lds, g, S, E); }
        GRID_SYNC();
        DBG(8, P, FF, 4096, nullptr, 0, 0);
        REP(16) if (PHM & 2048) { pg8::Gemm g{P, WB + WB_DN, M, 1024, FF, FF, FF}; pg8::StaticOrder S; S.init(M, 1024, G, cb);
          pg8::EpiY E{KV, 1024, part}; pg8::gemm_phase<pg8::EpiY>(lds, g, S, E); }
        GRID_SYNC();
        DBG(9, KV, 1024, 1024, nullptr, 0, 0);
        row_pass(nullptr, nullptr, KV, 1024, part, KA()->in[14] + layer * D, nullptr, 0, hb, rs, wid, lane);
        GRID_SYNC();
        DBGRET(10);
        if (PHM & 4096) { pg8::StaticOrder S; S.init(M, 1024, G, cb);
          REP(32) { pg8::Gemm g{hb, WB + WB_PG, M, 1024, 1024, 1024, 1024}; pg8::EpiAct<0> E{P, 1024, rs}; pg8::gemm_phase<pg8::EpiAct<0>>(lds, g, S, E); }
          REP(32) { pg8::Gemm g{pb, WB + WB_PP, M, 1024, PLE, PLE, PLE}; pg8::EpiY E{KV, 1024, part}; pg8::gemm_phase<pg8::EpiY>(lds, g, S, E); } }
        GRID_SYNC();
        DBG(11, P, 1024, 1024, KV, 1024, 1024);
        row_pass(nullptr, layer == DEPTH - 1 ? hout : nullptr, KV, 1024, part, KA()->in[15] + layer * D, P, 1024, hb, rs, wid, lane);
        if (layer + 1 < DEPTH) convert_layer(KA(), layer + 1, lds, tid, wid, lane);
        GRID_SYNC();
        DBGRET(12);
    }
}
#undef WB
#undef tabA
#undef tabR
#undef rs
#undef part
#undef hb
#undef pb
#undef KV
#undef P
#undef hout

extern "C" void kernel_launch(void* const* d_in, const int* in_sizes, int n_in, void* d_out, int out_size, void* d_ws, size_t ws_size, hipStream_t stream) {
    static int grid = 0;
    if (grid == 0) {
        if (n_in != 16 || out_size != M * D || ws_size < WS_END) { fprintf(stderr, "kernel_launch: unexpected shapes/workspace (n_in %d out %d ws %zu)\n", n_in, out_size, ws_size); grid = -1; return; }
        int dev = 0, cus = 0, per_cu = 0;
        hipGetDevice(&dev); hipDeviceGetAttribute(&cus, hipDeviceAttributeMultiprocessorCount, dev);
        hipFuncSetAttribute((const void*)fwd_kernel, hipFuncAttributeMaxDynamicSharedMemorySize, LDS_BYTES);
        hipOccupancyMaxActiveBlocksPerMultiprocessor(&per_cu, (const void*)fwd_kernel, 512, LDS_BYTES);
        if (per_cu < 1) per_cu = 1;
        grid = cus * 1;
        (void)hipGetLastError();
    }
    if (grid < 0) return;
    if (hipMemsetAsync((char*)d_ws + WS_CTL, 0, XCD_BAR_WORDS * 4, stream) != hipSuccess) { fprintf(stderr, "memset failed\n"); return; }
    Args a{};
    for (int i = 0; i < 16; ++i) a.in[i] = (const float*)d_in[i];
    a.out = (float*)d_out; a.ws = (unsigned char*)d_ws;
    void* args[] = {&a};
    hipError_t e = hipLaunchCooperativeKernel((const void*)fwd_kernel, dim3(grid), dim3(512), args, LDS_BYTES, stream);
    if (e != hipSuccess) fprintf(stderr, "cooperative launch failed: %s (grid %d)\n", hipGetErrorString(e), grid);
}
```
